# Optimizing an MI355X kernel written in HIP

```python
import jax
import jax.numpy as jnp
from jax import lax
import numpy as np

D_MODEL = 1024
BATCH = 8
SEQ = 4096
DEPTH = 2

GRID_W = 64
CTX_LEN = 256
N_EVEN = (DEPTH + 1) // 2
N_ODD = DEPTH // 2
NORM_EPS = 1e-6

CONV_WIDTH = D_MODEL // 2
CONV_TAPS = 3
RWKV_HEAD = 64
RWKV_HEADS = (D_MODEL // 2) // RWKV_HEAD
RWKV_WIDTH = RWKV_HEADS * RWKV_HEAD
DECAY_LORA = 64
ICLR_LORA = 64
RWKV_GN_EPS = 64e-5
A_COLS = 4 * CONV_WIDTH
RWKV_SHIFT_COLS = 3 * RWKV_WIDTH + DECAY_LORA + ICLR_LORA
RWKV_SPLITS = (RWKV_WIDTH, 2 * RWKV_WIDTH, 3 * RWKV_WIDTH, 3 * RWKV_WIDTH + DECAY_LORA)
EV_PROJ = A_COLS + RWKV_SHIFT_COLS + RWKV_WIDTH
EV_MIX = CONV_WIDTH + RWKV_WIDTH

MLA_HEADS = 8
QK_NOPE = 128
QK_ROPE = 64
V_HEAD = 128
Q_LORA = 384
KV_LORA = 256
MLA_WIDTH = MLA_HEADS * V_HEAD
Z_OFF = Q_LORA + KV_LORA + QK_ROPE
OD_PROJ = Z_OFF + MLA_WIDTH
SM_SCALE = (QK_NOPE + QK_ROPE) ** -0.5
ROPE_THETA = 10000.0
ROPE_PAIRS = QK_ROPE // 4
Q_BLOCK = 128

kernel_name = 'hybrid_conv_rwkv7_mla_prefix_dit'


def rms_norm(x, w):
    xf = x.astype(jnp.float32)
    y = xf * lax.rsqrt(jnp.mean(xf * xf, axis=-1, keepdims=True) + NORM_EPS)
    return (y * w.astype(jnp.float32)).astype(x.dtype)


def shift_prev(u):
    return jnp.pad(u, ((0, 0), (1, 0), (0, 0)))[:, :-1]


def shift_next(u):
    return jnp.pad(u, ((0, 0), (0, 1), (0, 0)))[:, 1:]


def to_heads(t):
    return t.reshape(t.shape[:-1] + (RWKV_HEADS, RWKV_HEAD))


def axial_rope_tables(n):
    rows = n // GRID_W
    row = jnp.repeat(jnp.arange(rows, dtype=jnp.float32), GRID_W)
    col = jnp.tile(jnp.arange(GRID_W, dtype=jnp.float32), rows)
    inv_freq = ROPE_THETA ** (-jnp.arange(ROPE_PAIRS, dtype=jnp.float32) / ROPE_PAIRS)
    ang = jnp.stack([row[:, None] * inv_freq, col[:, None] * inv_freq], axis=1)
    return jnp.cos(ang), jnp.sin(ang)


def apply_axial_rope(t, cos, sin):
    tf = t.astype(jnp.float32).reshape(t.shape[:-1] + (2, 2, ROPE_PAIRS))
    t1, t2 = tf[..., 0, :], tf[..., 1, :]
    out = jnp.stack([t1 * cos - t2 * sin, t2 * cos + t1 * sin], axis=-2)
    return out.reshape(t.shape).astype(t.dtype)


def short_conv_branch(pa, conv_w):
    u, gate_b, gate_c, z = jnp.split(pa, 4, axis=-1)
    cu = gate_c * u
    y = conv_w[0] * shift_prev(cu) + conv_w[1] * cu + conv_w[2] * shift_next(cu)
    return gate_b * y * jax.nn.silu(z)


def rwkv_prep(pr, mu, k_k):
    pr = pr.astype(jnp.float32)
    pr = pr + mu * (0.5 * (shift_prev(pr) + shift_next(pr)) - pr)
    r, k, v, wl, al = jnp.split(pr, RWKV_SPLITS, axis=-1)
    kk = to_heads(k * k_k)
    kk = kk / jnp.maximum(jnp.linalg.norm(kk, axis=-1, keepdims=True), 1e-12)
    return to_heads(r), k, to_heads(v), wl, al, kk


def rwkv_direction(k, wl, al, kk, w0, w2, a0, a2, k_a):
    w_log = -jax.nn.softplus(-(w0 + jnp.tanh(wl) @ w2)) - 0.5
    decay = jnp.exp(-jnp.exp(w_log))
    iclr = jax.nn.sigmoid(a0 + al @ a2)
    k_dir = k * (1.0 + (iclr - 1.0) * k_a)
    return to_heads(decay), to_heads(k_dir), kk * to_heads(iclr)


def rwkv7_scan(r, decay, k, v, a_vec, b_vec, s0, reverse):
    def step(S, inp):
        r_t, w_t, k_t, v_t, a_t, b_t = inp
        sa = jnp.einsum('bhij,bhj->bhi', S, a_t)
        S = S * w_t[:, :, None, :] + sa[..., None] * b_t[:, :, None, :] + v_t[..., None] * k_t[:, :, None, :]
        return S, jnp.einsum('bhij,bhj->bhi', S, r_t)
    xs = tuple(jnp.moveaxis(t, 1, 0) for t in (r, decay, k, v, a_vec, b_vec))
    S, ys = lax.scan(step, s0, xs, reverse=reverse)
    return jnp.moveaxis(ys, 0, 1), S


def head_group_norm(y, w, b):
    mean = jnp.mean(y, axis=-1, keepdims=True)
    var = jnp.mean(jnp.square(y - mean), axis=-1, keepdims=True)
    yn = (y - mean) * lax.rsqrt(var + RWKV_GN_EPS)
    return yn * w.reshape(RWKV_HEADS, RWKV_HEAD) + b.reshape(RWKV_HEADS, RWKV_HEAD)


def even_output(p, y, bon, conv_w, lnx_w, lnx_b, w_out):
    a_out = short_conv_branch(p[..., :A_COLS], conv_w)
    z_b = p[..., A_COLS + RWKV_SHIFT_COLS:]
    rw = head_group_norm(y, lnx_w, lnx_b) + bon
    b_out = rw.reshape(rw.shape[:2] + (RWKV_WIDTH,)) * jax.nn.silu(z_b.astype(jnp.float32))
    return jnp.concatenate([a_out, b_out.astype(p.dtype)], axis=-1) @ w_out


def even_mixer(h_ctx, h_lat, w_in, conv_w, mu, k_k, k_a, w0, w2, a0, a2, r_k, lnx_w, lnx_b, w_out, need_ctx):
    p_all = (h_ctx @ w_in, h_lat @ w_in)
    streams = [rwkv_prep(p[..., A_COLS:A_COLS + RWKV_SHIFT_COLS], mu, k_k) for p in p_all]
    batch = h_lat.shape[0]
    y_sum = [0.0, 0.0]
    bonus = [0.0, 0.0]
    for d, reverse in enumerate((False, True)):
        state = jnp.zeros((batch, RWKV_HEADS, RWKV_HEAD, RWKV_HEAD), jnp.float32)
        for s, (r, k, v, wl, al, kk) in enumerate(streams):
            decay, k_dir, b_vec = rwkv_direction(k, wl, al, kk, w0[d], w2[d], a0[d], a2[d], k_a)
            y, state = rwkv7_scan(r, decay, k_dir, v, -kk, b_vec, state, reverse)
            y_sum[s] = y_sum[s] + y
            bonus[s] = bonus[s] + jnp.sum(r * k_dir * r_k, axis=-1, keepdims=True) * v
    y_lat = even_output(p_all[1], y_sum[1], bonus[1], conv_w, lnx_w, lnx_b, w_out)
    y_ctx = even_output(p_all[0], y_sum[0], bonus[0], conv_w, lnx_w, lnx_b, w_out) if need_ctx else None
    return y_ctx, y_lat


def block_attention(q_nope, q_rope, k_nope, k_rope, v):
    batch, n_q = q_nope.shape[:2]
    n_blk = n_q // Q_BLOCK

    def to_blocks(t):
        return jnp.swapaxes(t.reshape((batch, n_blk, Q_BLOCK) + t.shape[2:]), 0, 1)

    def attend(qs):
        qn, qr = qs
        s = jnp.einsum('bqhd,bkhd->bhqk', qn, k_nope) + jnp.einsum('bqhr,bkr->bhqk', qr, k_rope)
        p = jax.nn.softmax(s.astype(jnp.float32), axis=-1).astype(v.dtype)
        return jnp.einsum('bhqk,bkhd->bqhd', p, v)

    o = lax.map(attend, (to_blocks(q_nope), to_blocks(q_rope)))
    return jnp.swapaxes(o, 0, 1).reshape((batch, n_q) + o.shape[3:])


def odd_mixer(h_ctx, h_lat, w_in, q_a_norm, kv_a_norm, w_qb, w_kvb, gq_nope, gq_rope, gk_nope, gk_rope, w_o, cos, sin, need_ctx):
    def keys_values(kv_in, rotary):
        kv_a, k_rope = kv_in[..., :KV_LORA], kv_in[..., KV_LORA:]
        kv = rms_norm(kv_a, kv_a_norm) @ w_kvb
        kv = kv.reshape(kv.shape[:2] + (MLA_HEADS, QK_NOPE + V_HEAD))
        k_nope = rms_norm(kv[..., :QK_NOPE], gk_nope)
        k_rope = rms_norm(k_rope, gk_rope)
        if rotary:
            k_rope = apply_axial_rope(k_rope, cos, sin)
        return k_nope, k_rope, kv[..., QK_NOPE:]

    def queries(q_a, rotary):
        q = rms_norm(q_a, q_a_norm) @ w_qb
        q = q.reshape(q.shape[:2] + (MLA_HEADS, QK_NOPE + QK_ROPE))
        q_nope = rms_norm(q[..., :QK_NOPE], gq_nope) * SM_SCALE
        q_rope = rms_norm(q[..., QK_NOPE:], gq_rope) * SM_SCALE
        if rotary:
            q_rope = apply_axial_rope(q_rope, cos[:, None], sin[:, None])
        return q_nope, q_rope

    def out(o, z):
        return (o.reshape(o.shape[:2] + (MLA_WIDTH,)) * jax.nn.silu(z)) @ w_o

    kn_c, kr_c, v_c = keys_values(h_ctx @ w_in[:, Q_LORA:Z_OFF], False)
    p = h_lat @ w_in
    kn_l, kr_l, v_l = keys_values(p[..., Q_LORA:Z_OFF], True)
    qn, qr = queries(p[..., :Q_LORA], True)
    k_nope = jnp.concatenate([kn_c, kn_l], axis=1)
    k_rope = jnp.concatenate([kr_c, kr_l], axis=1)
    v = jnp.concatenate([v_c, v_l], axis=1)
    y_lat = out(block_attention(qn, qr, k_nope, k_rope, v), p[..., Z_OFF:])
    y_ctx = None
    if need_ctx:
        qn_c, qr_c = queries(h_ctx @ w_in[:, :Q_LORA], False)
        y_ctx = out(block_attention(qn_c, qr_c, kn_c, kr_c, v_c), h_ctx @ w_in[:, Z_OFF:])
    return y_ctx, y_lat


def setup_inputs(seed: int = 0) -> dict:
    key = jax.random.key(seed)
    ks = iter(jax.random.split(key, 40))

    def nrm(shape, scale):
        return scale * jax.random.normal(next(ks), shape, jnp.float32)

    D = D_MODEL
    frac = jnp.arange(RWKV_WIDTH, dtype=jnp.float32) / (RWKV_WIDTH - 1)
    decay_base = -6.0 + 5.0 * frac ** 0.9
    return {
        'x': nrm((BATCH, SEQ, D), 1.0),
        'c': nrm((BATCH, D), 1.0),
        'ctx': nrm((BATCH, CTX_LEN, D), 1.0),
        'c_ctx': nrm((D,), 1.0),
        'ada_w': nrm((DEPTH, D, 3 * D), 0.5 * D ** -0.5),
        'ada_b': nrm((DEPTH, 3 * D), 0.02),
        'norm_w': 1.0 + nrm((DEPTH, D), 0.02),
        'ev_w_in': nrm((N_EVEN, D, EV_PROJ), D ** -0.5),
        'ev_conv_w': nrm((N_EVEN, CONV_TAPS, CONV_WIDTH), CONV_TAPS ** -0.5),
        'ev_mu': jax.random.uniform(next(ks), (N_EVEN, RWKV_SHIFT_COLS), jnp.float32),
        'ev_k_k': 0.85 + nrm((N_EVEN, RWKV_WIDTH), 0.02),
        'ev_k_a': 1.0 + nrm((N_EVEN, RWKV_WIDTH), 0.02),
        'ev_w0': decay_base + nrm((N_EVEN, 2, RWKV_WIDTH), 0.1),
        'ev_w2': nrm((N_EVEN, 2, DECAY_LORA, RWKV_WIDTH), 0.5 * DECAY_LORA ** -0.5),
        'ev_a0': nrm((N_EVEN, 2, RWKV_WIDTH), 0.1),
        'ev_a2': nrm((N_EVEN, 2, ICLR_LORA, RWKV_WIDTH), 0.5 * ICLR_LORA ** -0.5),
        'ev_r_k': nrm((N_EVEN, RWKV_HEADS, RWKV_HEAD), 0.1),
        'ev_lnx_w': 1.0 + nrm((N_EVEN, RWKV_WIDTH), 0.02),
        'ev_lnx_b': nrm((N_EVEN, RWKV_WIDTH), 0.02),
        'ev_w_out': nrm((N_EVEN, EV_MIX, D), EV_MIX ** -0.5),
        'od_w_in': nrm((N_ODD, D, OD_PROJ), D ** -0.5),
        'od_q_a_norm': 1.0 + nrm((N_ODD, Q_LORA), 0.02),
        'od_kv_a_norm': 1.0 + nrm((N_ODD, KV_LORA), 0.02),
        'od_w_qb': nrm((N_ODD, Q_LORA, MLA_HEADS * (QK_NOPE + QK_ROPE)), Q_LORA ** -0.5),
        'od_w_kvb': nrm((N_ODD, KV_LORA, MLA_HEADS * (QK_NOPE + V_HEAD)), KV_LORA ** -0.5),
        'od_gq_nope': 1.0 + nrm((N_ODD, QK_NOPE), 0.02),
        'od_gq_rope': 1.0 + nrm((N_ODD, QK_ROPE), 0.02),
        'od_gk_nope': 1.0 + nrm((N_ODD, QK_NOPE), 0.02),
        'od_gk_rope': 1.0 + nrm((N_ODD, QK_ROPE), 0.02),
        'od_w_o': nrm((N_ODD, MLA_WIDTH, D), MLA_WIDTH ** -0.5),
    }


def reference(x, c, ctx, c_ctx, ada_w, ada_b, norm_w, ev_w_in, ev_conv_w, ev_mu, ev_k_k, ev_k_a, ev_w0, ev_w2, ev_a0, ev_a2, ev_r_k, ev_lnx_w, ev_lnx_b, ev_w_out, od_w_in, od_q_a_norm, od_kv_a_norm, od_w_qb, od_w_kvb, od_gq_nope, od_gq_rope, od_gk_nope, od_gk_rope, od_w_o):
    cos, sin = axial_rope_tables(x.shape[1])
    silu_c = jax.nn.silu(c)
    silu_cc = jax.nn.silu(c_ctx)
    for layer in range(DEPTH):
        need_ctx = layer < DEPTH - 1
        shift, scale, gate = jnp.split(silu_c @ ada_w[layer] + ada_b[layer], 3, axis=-1)
        shift_c, scale_c, gate_c = jnp.split(silu_cc @ ada_w[layer] + ada_b[layer], 3, axis=-1)
        h_lat = rms_norm(x, norm_w[layer]) * (1.0 + scale[:, None]) + shift[:, None]
        h_ctx = rms_norm(ctx, norm_w[layer]) * (1.0 + scale_c) + shift_c
        j = layer // 2
        if layer % 2 == 0:
            y_ctx, y_lat = even_mixer(h_ctx, h_lat, ev_w_in[j], ev_conv_w[j], ev_mu[j], ev_k_k[j], ev_k_a[j],
                                      ev_w0[j], ev_w2[j], ev_a0[j], ev_a2[j], ev_r_k[j], ev_lnx_w[j], ev_lnx_b[j],
                                      ev_w_out[j], need_ctx)
        else:
            y_ctx, y_lat = odd_mixer(h_ctx, h_lat, od_w_in[j], od_q_a_norm[j], od_kv_a_norm[j], od_w_qb[j],
                                     od_w_kvb[j], od_gq_nope[j], od_gq_rope[j], od_gk_nope[j], od_gk_rope[j],
                                     od_w_o[j], cos, sin, need_ctx)
        x = x + gate[:, None] * y_lat
        if need_ctx:
            ctx = ctx + gate_c * y_ctx
    return x
```

```cpp
#include <hip/hip_runtime.h>
#include <hip/hip_cooperative_groups.h>
#include <cstdio>
namespace cg = cooperative_groups;
__device__ __forceinline__ int opaque_tid() { int t = threadIdx.x; asm volatile("" : "+v"(t)); return t; }
namespace pg8 {
#define PG8_LAS __attribute__((address_space(3)))
typedef unsigned short bf16_t;
typedef short bf16x8 __attribute__((ext_vector_type(8)));
typedef float f32x4 __attribute__((ext_vector_type(4)));
typedef unsigned u32x4 __attribute__((ext_vector_type(4)));
constexpr int BM = 256, BK = 64, HALF = 128, HTB = HALF * BK * 2  , STAGE_BYTES = 8 * HTB, NXCD = 8, WGM = 8;

__host__ __device__ __forceinline__ int lds_byte(int r, int c) { const int st = (r >> 4) * 2 + (c >> 5), rr = r & 15, cc = c & 31, ob = rr * 64 + cc * 2; return st * 1024 + (ob ^ (((ob >> 9) & 1) << 5)); }
__host__ __device__ __forceinline__ void stage_rc(int b, int& R, int& C) { const int st = b / 1024, sb = b % 1024, swz = sb ^ (((sb >> 9) & 1) << 5); R = (st >> 1) * 16 + swz / 64; C = (st & 1) * 32 + (swz % 64) / 2; }
__host__ __device__ __forceinline__ int perm32(int rho) { const int n = rho >> 4, i = rho & 15; return 8 * (i >> 2) + 4 * n + (i & 3); }

struct Unit { int pm, pn; };
struct Gemm { const bf16_t* A; const bf16_t* Bt; int M, N, K; };

struct StaticOrder {
    int nM, nN, nwg, G, c;
    __host__ __device__ void init(int M, int N, int G_, int c_) { nM = M / BM; nN = N / BM; nwg = nM * nN; G = G_; c = c_; }
    __host__ __device__ bool next(int i, Unit& u) const {
        const long L = (long)i * G + c; if (L >= nwg) return false;
        int wgid = (int)L; { const int q = nwg / NXCD, r = nwg % NXCD, xcd = wgid % NXCD, off = wgid / NXCD; wgid = (xcd < r ? xcd * (q + 1) : r * (q + 1) + (xcd - r) * q) + off; }
        const int nig = WGM * nN, gid = wgid / nig, fm = gid * WGM, gsz = (nM - fm) < WGM ? (nM - fm) : WGM;
        u.pm = fm + ((wgid % nig) % gsz); u.pn = (wgid % nig) / gsz; return true;
    }
    __device__ __forceinline__ void a_ready(const Unit&) const {}
    __device__ __forceinline__ void done(const Unit&) const {}
};
struct CountedOrder : StaticOrder {
    const unsigned* ready; unsigned need; unsigned* tmo;
    __device__ __forceinline__ void a_ready(const Unit& u) const {
        if (threadIdx.x < 64) {
            const unsigned long long t0 = __builtin_amdgcn_s_memrealtime(); unsigned polls = 0;
            while ((unsigned)__builtin_amdgcn_readfirstlane(__hip_atomic_load(ready + 64 * u.pm, __ATOMIC_RELAXED, __HIP_MEMORY_SCOPE_AGENT)) < need) {
                if ((++polls & 255u) == 0u && __builtin_amdgcn_readfirstlane(__hip_atomic_load(tmo, __ATOMIC_RELAXED, __HIP_MEMORY_SCOPE_AGENT)) != 0u) break;
                if (__builtin_amdgcn_s_memrealtime() - t0 > 2000000ull) {
                    if (threadIdx.x == 0) { unsigned expect = 0u; __hip_atomic_compare_exchange_strong(tmo + 1, &expect, 0x600u | (unsigned)(u.pm & 0xff), __ATOMIC_RELAXED, __ATOMIC_RELAXED, __HIP_MEMORY_SCOPE_AGENT); __hip_atomic_store(tmo, 1u, __ATOMIC_RELAXED, __HIP_MEMORY_SCOPE_AGENT); }
                    break; }
                __builtin_amdgcn_s_sleep(2); }
            __builtin_amdgcn_fence(__ATOMIC_ACQUIRE, "agent");
            asm volatile("s_waitcnt vmcnt(0)" ::: "memory");
        }
#if !defined(BROKEN_HOOK_NO_BARRIER)
        asm volatile("" ::: "memory"); __builtin_amdgcn_s_barrier(); asm volatile("" ::: "memory");
#endif
    }
};

__device__ __forceinline__ unsigned cvt_pk_bf16(float lo, float hi) { unsigned r; asm volatile("v_cvt_pk_bf16_f32 %0, %1, %2" : "=v"(r) : "v"(lo), "v"(hi)); return r; }
typedef float f32x2 __attribute__((ext_vector_type(2)));
__device__ __forceinline__ f32x2 gelu_pk(f32x2 v) {
    const f32x2 av = __builtin_elementwise_abs(v), d = av * 0.2316418882f + 1.0f;
    f32x2 t; t.x = __builtin_amdgcn_rcpf(d.x); t.y = __builtin_amdgcn_rcpf(d.y);
    f32x2 q = t * 0.5307027145f + (-0.7265760135f); q = q * t + 0.7107068705f; q = q * t + (-0.142248368f); q = q * t + 0.127414796f; q = q * t;
    const f32x2 s = (v * v) * (-0.72134752044f);
    f32x2 e; e.x = __builtin_amdgcn_exp2f(s.x); e.y = __builtin_amdgcn_exp2f(s.y);
    const f32x2 m = v * (q * e), r = v - m;
    f32x2 o; o.x = v.x < 0.f ? m.x : r.x; o.y = v.y < 0.f ? m.y : r.y; return o;
}

struct EpiF32 {
    static constexpr bool PERM = false, AFTER_DRAIN = false;
    float* C; int ldc; const float* bias;
    __device__ __forceinline__ void operator()(const f32x4 (&acc)[2][2][4][2], const Unit& u, int wr, int wc, int fr, int fq) const {
        const int row0 = u.pm * BM + wr * 64 + fr, col0 = u.pn * BM + wc * 32 + 4 * fq;
        f32x4 bv[2][2];
#pragma unroll
        for (int bj = 0; bj < 2; ++bj)
#pragma unroll
            for (int n = 0; n < 2; ++n) bv[bj][n] = bias ? *(const f32x4*)(bias + col0 + bj * HALF + n * 16) : (f32x4){0.f, 0.f, 0.f, 0.f};
#pragma unroll
        for (int ai = 0; ai < 2; ++ai)
#pragma unroll
            for (int m = 0; m < 4; ++m) { float* rowp = C + (size_t)(row0 + ai * HALF + m * 16) * ldc + col0;
#pragma unroll
                for (int bj = 0; bj < 2; ++bj)
#pragma unroll
                    for (int n = 0; n < 2; ++n) *(f32x4*)(rowp + bj * HALF + n * 16) = acc[ai][bj][m][n] + bv[bj][n]; }
    }
};
template <int ACT  > struct EpiBf16 {
    static constexpr bool PERM = true, AFTER_DRAIN = false;
    bf16_t* O; int ldc; const float* bias; int split_cols; size_t split_stride;
    __device__ __forceinline__ void operator()(const f32x4 (&acc)[2][2][4][2], const Unit& u, int wr, int wc, int fr, int fq) const {
        const int row0 = u.pm * BM + wr * 64 + fr; int colt = u.pn * BM; bf16_t* base = O;
        if (split_cols) { const int t = colt / split_cols; base += (size_t)t * split_stride; colt -= t * split_cols; }
        const int col0 = colt + wc * 32 + 8 * fq, bcol0 = u.pn * BM + wc * 32 + 8 * fq;
        f32x4 bv[2][2];
#pragma unroll
        for (int bj = 0; bj < 2; ++bj)
#pragma unroll
            for (int n = 0; n < 2; ++n) bv[bj][n] = bias ? *(const f32x4*)(bias + bcol0 + bj * HALF + 4 * n) : (f32x4){0.f, 0.f, 0.f, 0.f};
#pragma unroll
        for (int ai = 0; ai < 2; ++ai)
#pragma unroll
            for (int m = 0; m < 4; ++m) { bf16_t* rowp = base + (size_t)(row0 + ai * HALF + m * 16) * ldc + col0;
#pragma unroll
                for (int bj = 0; bj < 2; ++bj) { f32x4 v0 = acc[ai][bj][m][0] + bv[bj][0], v1 = acc[ai][bj][m][1] + bv[bj][1];
                    if (ACT == 1) { f32x2 a = gelu_pk((f32x2){v0[0], v0[1]}), b = gelu_pk((f32x2){v0[2], v0[3]}), c = gelu_pk((f32x2){v1[0], v1[1]}), d = gelu_pk((f32x2){v1[2], v1[3]});
                        v0 = (f32x4){a.x, a.y, b.x, b.y}; v1 = (f32x4){c.x, c.y, d.x, d.y}; }
                    if (ACT == 2) {
#pragma unroll
                        for (int j = 0; j < 4; ++j) { v0[j] = 0.5f * v0[j] * (1.0f + erff(v0[j] * 0.70710678f)); v1[j] = 0.5f * v1[j] * (1.0f + erff(v1[j] * 0.70710678f)); } }
                    u32x4 w; w.x = cvt_pk_bf16(v0[0], v0[1]); w.y = cvt_pk_bf16(v0[2], v0[3]); w.z = cvt_pk_bf16(v1[0], v1[1]); w.w = cvt_pk_bf16(v1[2], v1[3]);
                    *(u32x4*)(rowp + bj * HALF) = w; } }
    }
};

template <class Epi, class Sched, bool STAMP = false>
__device__ __forceinline__ void gemm_phase(PG8_LAS unsigned char* lds, const Gemm g, const Sched& S, const Epi& E, unsigned long long* stamps) {
    const int tid = opaque_tid(), wid = __builtin_amdgcn_readfirstlane(tid >> 6), lane = tid & 63, wr = wid >> 2, wc = wid & 3, fr = lane & 15, fq = lane >> 4;
    const int K = g.K, nt = K / BK;
    int ts_lo = 0, ts_hi = 0, nts = 0; const unsigned long long rt_entry = STAMP ? (unsigned long long)wall_clock64() : 0ull;
#define PG8_STAMP() do { if (STAMP && wid == 0 && nts < 64) { const unsigned long long _c = (unsigned long long)clock64(); \
        ts_lo = (lane == nts) ? (int)(unsigned)_c : ts_lo; ts_hi = (lane == nts) ? (int)(unsigned)(_c >> 32) : ts_hi; ++nts; } } while (0)
    PG8_STAMP();
    unsigned voffA[2], voffB[2];
#pragma unroll
    for (int i = 0; i < 2; ++i) { int R, C; stage_rc(tid * 16 + i * 8192, R, C); const int Rb = Epi::PERM ? ((R & ~31) + perm32(R & 31)) : R;
        voffA[i] = (unsigned)(R * K + C) * 2u; voffB[i] = (unsigned)(Rb * K + C) * 2u; }
    const size_t kstep = (size_t)(BK * 2);
    const size_t hstep = (size_t)HALF * K * 2;
    const size_t tstep = 2 * hstep;
    const unsigned ldsw = (unsigned)wid * 1024u;
    const int aoff = lds_byte(wr * 64 + fr, fq * 8), boff = lds_byte(wc * 32 + fr, fq * 8);
#define PG8_SA(b, h) (((b) * 2 + (h)) * HTB)
#define PG8_SB(b, h) ((4 + (b) * 2 + (h)) * HTB)
#define PG8_STAGE(bufoff, gbase, voff) do { _Pragma("unroll") for (int _i = 0; _i < 2; ++_i) \
        __builtin_amdgcn_global_load_lds((const unsigned*)((const char*)(gbase) + (voff)[_i]), (PG8_LAS unsigned*)(lds + (bufoff) + ldsw + _i * 8192), 16, 0, 0); } while (0)
#define PG8_LDA(dst, b, h) do { _Pragma("unroll") for (int m = 0; m < 4; ++m) _Pragma("unroll") for (int k = 0; k < 2; ++k) dst[m][k] = *(const PG8_LAS bf16x8*)(lds + PG8_SA(b, h) + aoff + m * 2048 + k * 1024); } while (0)
#define PG8_LDB(dst, b, h) do { _Pragma("unroll") for (int n = 0; n < 2; ++n) _Pragma("unroll") for (int k = 0; k < 2; ++k) dst[n][k] = *(const PG8_LAS bf16x8*)(lds + PG8_SB(b, h) + boff + n * 2048 + k * 1024); } while (0)
#define PG8_MMA(ai, bj, At, Bt) do { __builtin_amdgcn_s_setprio(1); _Pragma("unroll") for (int m = 0; m < 4; ++m) _Pragma("unroll") for (int n = 0; n < 2; ++n) _Pragma("unroll") for (int k = 0; k < 2; ++k) \
        acc[ai][bj][m][n] = __builtin_amdgcn_mfma_f32_16x16x32_bf16(Bt[n][k], At[m][k], acc[ai][bj][m][n], 0, 0, 0); __builtin_amdgcn_s_setprio(0); } while (0)
#define PG8_WAIT_V(n) asm volatile("s_waitcnt vmcnt(" #n ")" ::: "memory")
#define PG8_WAIT_L(n) asm volatile("s_waitcnt lgkmcnt(" #n ")" ::: "memory")
#define PG8_BAR __builtin_amdgcn_s_barrier()
#define PG8_SCHED __builtin_amdgcn_sched_barrier(0)
    Unit cur, nxt; int ui = 0;
    if (!S.next(0, cur)) return;
    f32x4 acc[2][2][4][2];
#pragma unroll
    for (int a = 0; a < 2; ++a)
#pragma unroll
        for (int b = 0; b < 2; ++b)
#pragma unroll
            for (int m = 0; m < 4; ++m)
#pragma unroll
                for (int n = 0; n < 2; ++n) acc[a][b][m][n] = (f32x4){0.f, 0.f, 0.f, 0.f};
    bf16x8 At[4][2], B0[2][2], B1[2][2];
    const char* cA = (const char*)g.A + (size_t)cur.pm * tstep; const char* cB = (const char*)g.Bt + (size_t)cur.pn * tstep;
    S.a_ready(cur);
    PG8_STAGE(PG8_SB(0, 0), cB, voffB); PG8_STAGE(PG8_SA(0, 0), cA, voffA); PG8_STAGE(PG8_SB(0, 1), cB + hstep, voffB); PG8_STAGE(PG8_SA(0, 1), cA + hstep, voffA);
    if (wr == 1) PG8_BAR;
    PG8_WAIT_V(4); PG8_BAR;
    PG8_STAGE(PG8_SB(1, 0), cB + kstep, voffB); PG8_STAGE(PG8_SA(1, 0), cA + kstep, voffA); PG8_STAGE(PG8_SB(1, 1), cB + hstep + kstep, voffB);
    PG8_WAIT_V(6); PG8_BAR;
    PG8_STAMP();
    for (;;) {
        const bool has_next = S.next(ui + 1, nxt);
        const char* nA = has_next ? (const char*)g.A + (size_t)nxt.pm * tstep : cA; const char* nB = has_next ? (const char*)g.Bt + (size_t)nxt.pn * tstep : cB;
        for (int t = 0; t < nt; t += 2) {
            const bool last = (t == nt - 2);
            const char* a1 = cA + (size_t)(t + 1) * kstep;
            const char* a2 = last ? nA : cA + (size_t)(t + 2) * kstep; const char* b2 = last ? nB : cB + (size_t)(t + 2) * kstep;
            const char* a3 = a2 + kstep; const char* b3 = b2 + kstep;
            if (last && has_next) S.a_ready(nxt);
            PG8_LDB(B0, 0, 0); PG8_SCHED; PG8_LDA(At, 0, 0); PG8_STAGE(PG8_SA(1, 1), a1 + hstep, voffA);
            PG8_WAIT_L(8); PG8_BAR; PG8_WAIT_L(0); PG8_MMA(0, 0, At, B0); PG8_BAR; PG8_SCHED;
            PG8_LDB(B1, 0, 1); PG8_STAGE(PG8_SB(0, 0), b2, voffB);
            PG8_BAR; PG8_WAIT_L(0); PG8_MMA(0, 1, At, B1); PG8_BAR;
            PG8_LDA(At, 0, 1); PG8_STAGE(PG8_SA(0, 0), a2, voffA);
            PG8_BAR; PG8_WAIT_L(0); PG8_MMA(1, 0, At, B0); PG8_BAR; PG8_SCHED;
            PG8_STAGE(PG8_SB(0, 1), b2 + hstep, voffB);
            PG8_WAIT_V(6); PG8_BAR; PG8_MMA(1, 1, At, B1); PG8_BAR;
            PG8_LDB(B0, 1, 0); PG8_SCHED; PG8_LDA(At, 1, 0); PG8_STAGE(PG8_SA(0, 1), a2 + hstep, voffA);
            PG8_WAIT_L(8); PG8_BAR; PG8_WAIT_L(0); PG8_MMA(0, 0, At, B0); PG8_BAR; PG8_SCHED;
            PG8_LDB(B1, 1, 1); PG8_STAGE(PG8_SB(1, 0), b3, voffB);
            PG8_BAR; PG8_WAIT_L(0); PG8_MMA(0, 1, At, B1); PG8_BAR;
            PG8_LDA(At, 1, 1); PG8_STAGE(PG8_SA(1, 0), a3, voffA);
            PG8_BAR; PG8_WAIT_L(0); PG8_MMA(1, 0, At, B0); PG8_BAR; PG8_SCHED;
            PG8_STAGE(PG8_SB(1, 1), b3 + hstep, voffB);
            PG8_WAIT_V(6); PG8_BAR; PG8_MMA(1, 1, At, B1); PG8_BAR;
        }
        PG8_STAMP();
        if constexpr (!Epi::AFTER_DRAIN) { E(acc, cur, wr, wc, fr, fq); S.done(cur); }
        PG8_STAMP();
        if (!has_next) break;
#pragma unroll
        for (int a = 0; a < 2; ++a)
#pragma unroll
            for (int b = 0; b < 2; ++b)
#pragma unroll
                for (int m = 0; m < 4; ++m)
#pragma unroll
                    for (int n = 0; n < 2; ++n) acc[a][b][m][n] = (f32x4){0.f, 0.f, 0.f, 0.f};
        cur = nxt; cA = nA; cB = nB; ++ui;
    }
    PG8_WAIT_V(0);
    if (wr == 0) PG8_BAR;
    PG8_BAR;
    if constexpr (Epi::AFTER_DRAIN) { E.fused(acc, cur, wr, wc, fr, fq, lds, wid, lane); S.done(cur); }
    PG8_STAMP();
    if (STAMP && wid == 0) { stamps[lane] = lane < nts ? (((unsigned long long)(unsigned)ts_hi << 32) | (unsigned)ts_lo) : 0ull;
        if (lane == 62) stamps[62] = rt_entry; if (lane == 63) stamps[63] = (unsigned long long)wall_clock64(); }
#undef PG8_STAMP
#undef PG8_SA
#undef PG8_SB
#undef PG8_STAGE
#undef PG8_LDA
#undef PG8_LDB
#undef PG8_MMA
#undef PG8_WAIT_V
#undef PG8_WAIT_L
#undef PG8_BAR
#undef PG8_SCHED
}
}

typedef unsigned short bf16_t;
typedef short bf16x8 __attribute__((ext_vector_type(8)));
typedef short s16x4 __attribute__((ext_vector_type(4)));
typedef float f32x4 __attribute__((ext_vector_type(4)));
typedef float f32x16 __attribute__((ext_vector_type(16)));
typedef unsigned u32x4 __attribute__((ext_vector_type(4)));
typedef unsigned u32x2 __attribute__((ext_vector_type(2)));
typedef _Float16 h16x8 __attribute__((ext_vector_type(8)));
typedef _Float16 h16x4 __attribute__((ext_vector_type(4)));

constexpr int NB = 8, SEQ = 4096, CL = 256, DM = 1024, TPB = 4352  , MR = NB * TPB  ;
constexpr float SM_SCALE = 0.07216878364870322f;

constexpr size_t OFF_W0T = 0, OFF_WLT = 8912896, OFF_WOUT0T = 9961472, OFF_W1T = 12058624, OFF_WQBT = 15728640, OFF_WKVBT = 16908288, OFF_WOT = 17956864,
                 OFF_MOD = 20054016, OFF_R1 = 20275200;
constexpr size_t SZ_M512_2 = (size_t)MR * 512 * 2  , SZ_M1024_2 = (size_t)MR * 1024 * 2  ;
constexpr size_t OFF_H = OFF_R1, OFF_R = OFF_R1, OFF_K = OFF_R1 + SZ_M512_2, OFF_V = OFF_R1 + 2 * SZ_M512_2, OFF_NKK = OFF_R1 + 3 * SZ_M512_2, OFF_DELTA0 = OFF_R1;
constexpr size_t OFF_R2 = OFF_R1 + (size_t)MR * 1024 * 4  , OFF_RW = OFF_R2, OFF_E16 = OFF_R2  , OFF_MIX = OFF_R2;
constexpr size_t OFF_R3 = OFF_R2 + (size_t)MR * 1664 * 2, OFF_CUG = OFF_R3, OFF_ZB = OFF_R3 + SZ_M1024_2;
constexpr size_t OFF_R4 = OFF_R3 + SZ_M1024_2 + SZ_M512_2, OFF_IC16 = OFF_R4  ;
constexpr size_t OFF_R5 = OFF_R4 + SZ_M1024_2, OFF_Y16 = OFF_R5  , OFF_LA = OFF_R5;
constexpr size_t WS_NEED0 = OFF_R5 + SZ_M1024_2;
constexpr size_t OFF_H1 = OFF_R1 + SZ_M1024_2, OFF_QAN = OFF_H1, OFF_KVAN = OFF_H1 + (size_t)MR * 384 * 2, OFF_OG = OFF_H1;
constexpr size_t OFF_Z = OFF_R2, OFF_P1S = OFF_R2 + SZ_M1024_2, OFF_QRAW = OFF_P1S, OFF_KVRAW = OFF_QRAW + (size_t)MR * 1536 * 2, OFF_KROPE = OFF_KVRAW + (size_t)MR * 2048 * 2;
constexpr size_t WS_NEED1 = OFF_KROPE + (size_t)MR * 64 * 2;
constexpr size_t WS_NEED = WS_NEED0 > WS_NEED1 ? WS_NEED0 : WS_NEED1;
static_assert(WS_NEED <= 536870912, "workspace");
static_assert(OFF_R1 % 256 == 0 && OFF_R2 % 256 == 0 && OFF_R3 % 256 == 0, "align");

struct Params { const float* in[30]; float* out; unsigned char* ws; };

__device__ __forceinline__ unsigned cvtpk(float lo, float hi) { unsigned r; asm("v_cvt_pk_bf16_f32 %0, %1, %2" : "=v"(r) : "v"(lo), "v"(hi)); return r; }
__device__ __forceinline__ u32x4 pack8(const float (&v)[8]) { return (u32x4){cvtpk(v[0], v[1]), cvtpk(v[2], v[3]), cvtpk(v[4], v[5]), cvtpk(v[6], v[7])}; }
__device__ __forceinline__ void unpack8(u32x4 w, float (&v)[8]) {
  v[0] = __uint_as_float(w.x << 16); v[1] = __uint_as_float(w.x & 0xffff0000u); v[2] = __uint_as_float(w.y << 16); v[3] = __uint_as_float(w.y & 0xffff0000u);
  v[4] = __uint_as_float(w.z << 16); v[5] = __uint_as_float(w.z & 0xffff0000u); v[6] = __uint_as_float(w.w << 16); v[7] = __uint_as_float(w.w & 0xffff0000u); }
__device__ __forceinline__ void ld8bf(const bf16_t* p, float (&v)[8]) { unpack8(*(const u32x4*)p, v); }
__device__ __forceinline__ void st8bf(bf16_t* p, const float (&v)[8]) { *(u32x4*)p = pack8(v); }
__device__ __forceinline__ void ld8f(const float* p, float (&v)[8]) { const f32x4 a = *(const f32x4*)p, b = *(const f32x4*)(p + 4); v[0] = a[0]; v[1] = a[1]; v[2] = a[2]; v[3] = a[3]; v[4] = b[0]; v[5] = b[1]; v[6] = b[2]; v[7] = b[3]; }
__device__ __forceinline__ void ld8h(const _Float16* p, float (&v)[8]) { const h16x8 a = *(const h16x8*)p;
#pragma unroll
  for (int i = 0; i < 8; ++i) v[i] = (float)a[i]; }
__device__ __forceinline__ float sigmoidf_(float x) { return __builtin_amdgcn_rcpf(1.f + __expf(-x)); }
__device__ __forceinline__ float siluf_(float x) { return x * sigmoidf_(x); }
__device__ __forceinline__ f32x4 silu4(f32x4 x) { return (f32x4){siluf_(x[0]), siluf_(x[1]), siluf_(x[2]), siluf_(x[3])}; }
__device__ __forceinline__ void st8(bf16_t* d, f32x4 a, f32x4 b) { *(u32x4*)d = (u32x4){cvtpk(a[0], a[1]), cvtpk(a[2], a[3]), cvtpk(b[0], b[1]), cvtpk(b[2], b[3])}; }
template <int CTRL> __device__ __forceinline__ float dppmov(float v) { return __int_as_float(__builtin_amdgcn_update_dpp(0, __float_as_int(v), CTRL, 0xF, 0xF, true)); }
__device__ __forceinline__ float red8(float x) { x += dppmov<0xB1>(x); x += dppmov<0x4E>(x); x += dppmov<0x141>(x); return x; }
__device__ __forceinline__ float wave_sum(float x) {
#pragma unroll
  for (int o = 32; o >= 1; o >>= 1) x += __shfl_xor(x, o);
  return x; }

template <class F> struct EpiT { static constexpr bool PERM = true, AFTER_DRAIN = false; F f;
  __device__ __forceinline__ void operator()(const f32x4 (&acc)[2][2][4][2], const pg8::Unit& u, int wr, int wc, int fr, int fq) const {
    const int c = wc * 32 + 8 * fq;
#pragma unroll
    for (int ai = 0; ai < 2; ++ai)
#pragma unroll
      for (int m = 0; m < 4; ++m) { const int row = u.pm * 256 + ai * 128 + wr * 64 + m * 16 + fr;
        f(row, u.pn, c, acc[ai][0][m][0], acc[ai][0][m][1], acc[ai][1][m][0], acc[ai][1][m][1]); } } };

template <class F> __device__ __forceinline__ void run_gemm(PG8_LAS unsigned char* lds, const bf16_t* A, const bf16_t* Bt, int M_, int N_, int K_, const F& f) {
  pg8::Gemm g{A, Bt, M_, N_, K_}; pg8::StaticOrder S; S.init(M_, N_, (int)gridDim.x, (int)blockIdx.x);
  EpiT<F> E{f};
  pg8::gemm_phase<EpiT<F>, pg8::StaticOrder, false>(lds, g, S, E, nullptr);
}

template <class MapF> __device__ __forceinline__ void transpose_w(const float* __restrict__ W, int K, int N, bf16_t* __restrict__ Wt, int Nout, MapF map, int gtid, int gn) {
  const int total = Nout * (K / 8);
  for (int q = gtid; q < total; q += gn) { const int n = q % Nout, k8 = q / Nout; const int src = map(n); float v[8];
#pragma unroll
    for (int i = 0; i < 8; ++i) v[i] = src >= 0 ? W[(size_t)(k8 * 8 + i) * N + src] : 0.f;
    st8bf(Wt + (size_t)n * K + k8 * 8, v); }
}
__device__ __forceinline__ void p0_prologue(const Params& p, unsigned char* ldsg) {
  const int tid = opaque_tid(), wid = tid >> 6, lane = tid & 63;
  float* sc = (float*)ldsg; float* red = sc + 9 * 1024;
  float* mod = (float*)(p.ws + OFF_MOD);
  for (int it = blockIdx.x; it < 96; it += gridDim.x) {
    for (int i = tid; i < 9 * 1024; i += 512) { const int bb = i >> 10, k = i & 1023; const float c = bb < 8 ? p.in[1][bb * 1024 + k] : p.in[3][k]; sc[i] = siluf_(c); }
    __syncthreads();
    const int l = it / 48, n0 = (it % 48) * 64; const float* W = p.in[4] + (size_t)l * 1024 * 3072 + n0 + lane; const int k0 = wid * 128;
    float acc[9];
#pragma unroll
    for (int bb = 0; bb < 9; ++bb) acc[bb] = 0.f;
#pragma unroll 16
    for (int k = 0; k < 128; ++k) { const float w = W[(size_t)(k0 + k) * 3072];
#pragma unroll
      for (int bb = 0; bb < 9; ++bb) acc[bb] += sc[bb * 1024 + k0 + k] * w; }
#pragma unroll
    for (int bb = 0; bb < 9; ++bb) red[(wid * 9 + bb) * 64 + lane] = acc[bb];
    __syncthreads();
    for (int i = tid; i < 9 * 64; i += 512) { const int bb = i >> 6, ln = i & 63; float s = 0.f;
#pragma unroll
      for (int w = 0; w < 8; ++w) s += red[(w * 9 + bb) * 64 + ln];
      mod[(l * 9 + bb) * 3072 + n0 + ln] = s + p.in[5][l * 3072 + n0 + ln]; }
    __syncthreads();
  }
  const int gtid = blockIdx.x * 512 + tid, gn = gridDim.x * 512;
  transpose_w(p.in[7], 1024, 4224, (bf16_t*)(p.ws + OFF_W0T), 4352, [](int n) { const int pn = n >> 8, c = n & 255, half = c >> 7, ci = c & 127;
      if (pn < 4) return half ? 1024 + 128 * pn + ci : 128 * pn + ci;
      if (pn < 8) return half ? 1536 + 128 * (pn - 4) + ci : 512 + 128 * (pn - 4) + ci;
      if (pn < 14) return 2048 + 256 * (pn - 8) + c;
      if (pn == 14) return half ? 3712 + ci : 3584 + ci;
      if (pn == 15) return 3840 + c;
      return half ? -1 : 4096 + ci; }, gtid, gn);
  { bf16_t* Wl = (bf16_t*)(p.ws + OFF_WLT);
    for (int q = gtid; q < 2048 * 32; q += gn) { const int n = q & 2047, k8 = q >> 11, dir = n >> 10, kind = (n >> 9) & 1, ch = n & 511, kk0 = k8 * 8; float v[8];
#pragma unroll
      for (int i = 0; i < 8; ++i) { float x = 0.f;
        if (kind == 0 && kk0 < 64) x = p.in[13][(size_t)(dir * 64 + kk0 + i) * 512 + ch];
        if (kind == 1 && kk0 >= 64 && kk0 < 128) x = p.in[15][(size_t)(dir * 64 + kk0 - 64 + i) * 512 + ch];
        v[i] = x; }
      st8bf(Wl + (size_t)n * 256 + kk0, v); } }
  transpose_w(p.in[19], 1024, 1024, (bf16_t*)(p.ws + OFF_WOUT0T), 1024, [](int n) { return n; }, gtid, gn);
  transpose_w(p.in[20], 1024, 1728, (bf16_t*)(p.ws + OFF_W1T), 1792, [](int n) { return n < 704 ? n : (n < 768 ? -1 : n - 64); }, gtid, gn);
  transpose_w(p.in[23], 384, 1536, (bf16_t*)(p.ws + OFF_WQBT), 1536, [](int n) { return n; }, gtid, gn);
  transpose_w(p.in[24], 256, 2048, (bf16_t*)(p.ws + OFF_WKVBT), 2048, [](int n) { return n; }, gtid, gn);
  transpose_w(p.in[29], 1024, 1024, (bf16_t*)(p.ws + OFF_WOT), 1024, [](int n) { return n; }, gtid, gn);
}

__device__ __forceinline__ const float* xin_row(const Params& p, int g) { const int b = g / TPB, pos = g - b * TPB;
  return pos < CL ? p.in[2] + (size_t)(b * CL + pos) * DM : p.in[0] + (size_t)(b * SEQ + pos - CL) * DM; }
__device__ __forceinline__ void modnorm_phase(const Params& p, int l) {
  const int tid_ = opaque_tid(), wid = tid_ >> 6, lane = tid_ & 63, gw = blockIdx.x * 8 + wid, nw = gridDim.x * 8;
  const float* mod = (const float*)(p.ws + OFF_MOD); const float* nwp = p.in[6] + l * 1024;
  bf16_t* H = (bf16_t*)(p.ws + (l ? OFF_H1 : OFF_H)); const bf16_t* D0 = (const bf16_t*)(p.ws + OFF_DELTA0);
  for (int g = gw; g < MR; g += nw) { const int b = g / TPB, pos = g - b * TPB, bb = pos < CL ? 8 : b; const float* src = xin_row(p, g);
    f32x4 v[4]; float ss = 0.f;
#pragma unroll
    for (int i = 0; i < 4; ++i) { v[i] = *(const f32x4*)(src + i * 256 + lane * 4);
      if (l) { const u32x2 d = *(const u32x2*)(D0 + (size_t)g * 1024 + i * 256 + lane * 4);
        v[i][0] += __uint_as_float(d.x << 16); v[i][1] += __uint_as_float(d.x & 0xffff0000u); v[i][2] += __uint_as_float(d.y << 16); v[i][3] += __uint_as_float(d.y & 0xffff0000u); }
      ss += v[i][0] * v[i][0] + v[i][1] * v[i][1] + v[i][2] * v[i][2] + v[i][3] * v[i][3]; }
    ss = wave_sum(ss); const float rstd = rsqrtf(ss * (1.f / 1024.f) + 1e-6f); const float* md = mod + (l * 9 + bb) * 3072;
#pragma unroll
    for (int i = 0; i < 4; ++i) { const int col = i * 256 + lane * 4; const f32x4 w = *(const f32x4*)(nwp + col), sh = *(const f32x4*)(md + col), sl = *(const f32x4*)(md + 1024 + col);
      const f32x4 h = v[i] * rstd * w * (sl + 1.f) + sh; *(u32x2*)(H + (size_t)g * 1024 + col) = (u32x2){cvtpk(h[0], h[1]), cvtpk(h[2], h[3])}; } }
}

struct F0 { bf16_t* CUG; bf16_t* RW; bf16_t* ZB;
  __device__ __forceinline__ void operator()(int row, int pn, int c, f32x4 a0, f32x4 a1, f32x4 b0, f32x4 b1) const {
    if (pn < 4) st8(CUG + (size_t)row * 1024 + 128 * pn + c, a0 * b0, a1 * b1);
    else if (pn < 8) st8(CUG + (size_t)row * 1024 + 512 + 128 * (pn - 4) + c, a0 * silu4(b0), a1 * silu4(b1));
    else if (pn < 14) { bf16_t* d = RW + (size_t)row * 1664 + 256 * (pn - 8) + c; st8(d, a0, a1); st8(d + 128, b0, b1); }
    else if (pn == 14) { st8(RW + (size_t)row * 1664 + 1536 + c, a0, a1); st8(ZB + (size_t)row * 512 + c, silu4(b0), silu4(b1)); }
    else if (pn == 15) { st8(ZB + (size_t)row * 512 + 128 + c, silu4(a0), silu4(a1)); st8(ZB + (size_t)row * 512 + 256 + c, silu4(b0), silu4(b1)); }
    else st8(ZB + (size_t)row * 512 + 384 + c, silu4(a0), silu4(a1)); } };

__device__ __forceinline__ void rwkv_prep_phase(const Params& p) {
  const int tid_ = opaque_tid(), wid = tid_ >> 6, lane = tid_ & 63, gw = blockIdx.x * 8 + wid, nw = gridDim.x * 8;
  const bf16_t* RW = (const bf16_t*)(p.ws + OFF_RW); bf16_t* R = (bf16_t*)(p.ws + OFF_R); bf16_t* Kk = (bf16_t*)(p.ws + OFF_K); bf16_t* V = (bf16_t*)(p.ws + OFF_V);
  bf16_t* NKK = (bf16_t*)(p.ws + OFF_NKK); bf16_t* LA = (bf16_t*)(p.ws + OFF_LA);
  const float* mu = p.in[9]; const float* k_k = p.in[10];
  for (int g = gw; g < MR; g += nw) { const int pos = g % TPB; const bool hp = (pos != 0 && pos != CL), hn = (pos != CL - 1 && pos != TPB - 1);
    const bf16_t* cur = RW + (size_t)g * 1664;
#pragma unroll
    for (int part = 0; part < 3; ++part) { const int col = part * 512 + lane * 8; float c[8], pv[8], nx[8], m[8], o[8];
      ld8bf(cur + col, c);
      if (hp) ld8bf(cur - 1664 + col, pv); else {
#pragma unroll
        for (int i = 0; i < 8; ++i) pv[i] = 0.f; }
      if (hn) ld8bf(cur + 1664 + col, nx); else {
#pragma unroll
        for (int i = 0; i < 8; ++i) nx[i] = 0.f; }
      ld8f(mu + col, m);
#pragma unroll
      for (int i = 0; i < 8; ++i) o[i] = c[i] + m[i] * (0.5f * (pv[i] + nx[i]) - c[i]);
      if (part == 0) st8bf(R + (size_t)g * 512 + lane * 8, o);
      else if (part == 2) st8bf(V + (size_t)g * 512 + lane * 8, o);
      else { st8bf(Kk + (size_t)g * 512 + lane * 8, o); float kk[8], q[8]; ld8f(k_k + lane * 8, kk); float ss = 0.f;
#pragma unroll
        for (int i = 0; i < 8; ++i) { q[i] = o[i] * kk[i]; ss += q[i] * q[i]; }
        ss = red8(ss); const float inv = -1.f / fmaxf(sqrtf(ss), 1e-12f);
#pragma unroll
        for (int i = 0; i < 8; ++i) q[i] *= inv;
        st8bf(NKK + (size_t)g * 512 + lane * 8, q); } }
    if (lane < 32) { float o[8];
      if (lane < 16) { const int col = 1536 + lane * 8; float c[8], pv[8], nx[8], m[8];
        ld8bf(cur + col, c);
        if (hp) ld8bf(cur - 1664 + col, pv); else {
#pragma unroll
          for (int i = 0; i < 8; ++i) pv[i] = 0.f; }
        if (hn) ld8bf(cur + 1664 + col, nx); else {
#pragma unroll
          for (int i = 0; i < 8; ++i) nx[i] = 0.f; }
        ld8f(mu + col, m);
#pragma unroll
        for (int i = 0; i < 8; ++i) { o[i] = c[i] + m[i] * (0.5f * (pv[i] + nx[i]) - c[i]); if (lane < 8) o[i] = tanhf(o[i]); } }
      else {
#pragma unroll
        for (int i = 0; i < 8; ++i) o[i] = 0.f; }
      st8bf(LA + (size_t)g * 256 + lane * 8, o); } }
}

struct FL { _Float16* E0; _Float16* E1; _Float16* I0; _Float16* I1; const float* w0; const float* a0;
  __device__ __forceinline__ void operator()(int row, int pn, int c, f32x4 x0, f32x4 x1, f32x4 y0, f32x4 y1) const {
    const int dir = pn >> 2, kind = (pn >> 1) & 1, cb = 256 * (pn & 1) + c; const float* bias = (kind ? a0 : w0) + dir * 512; const float scl = kind ? 1.f : 0.6065306597126334f;
    _Float16* dst = E0 + (size_t)kind * (size_t)(I0 - E0) + (size_t)dir * ((size_t)MR * 512) + (size_t)row * 512 + cb; float bs[8]; h16x8 o;
    ld8f(bias + cb, bs);
#pragma unroll
    for (int i = 0; i < 4; ++i) { o[i] = (_Float16)(scl * sigmoidf_(bs[i] + x0[i])); o[4 + i] = (_Float16)(scl * sigmoidf_(bs[4 + i] + x1[i])); }
    *(h16x8*)dst = o;
    ld8f(bias + cb + 128, bs);
#pragma unroll
    for (int i = 0; i < 4; ++i) { o[i] = (_Float16)(scl * sigmoidf_(bs[i] + y0[i])); o[4 + i] = (_Float16)(scl * sigmoidf_(bs[4 + i] + y1[i])); }
    *(h16x8*)(dst + 128) = o; } };

constexpr int SC_CH = 32  , SC_STEP = 352  , SC_BUF = SC_CH * SC_STEP * 4  , SC_NCH = TPB / SC_CH  ;
__device__ __forceinline__ int scan_pos(int d, int sg) { return d == 0 ? sg : (sg < CL ? CL - 1 - sg : TPB + CL - 1 - sg); }
__device__ __forceinline__ void scan_phase(const Params& p, unsigned char* ldsg) {
  const int tid = opaque_tid(), wid = tid >> 6, lane = tid & 63;
  float* ybuf = (float*)(ldsg + 2 * SC_BUF);
  const bf16_t* R = (const bf16_t*)(p.ws + OFF_R); const bf16_t* Kk = (const bf16_t*)(p.ws + OFF_K); const bf16_t* V = (const bf16_t*)(p.ws + OFF_V); const bf16_t* NKK = (const bf16_t*)(p.ws + OFF_NKK);
  for (int item = blockIdx.x; item < 256; item += gridDim.x) {
    const int chain = item >> 1, rh = item & 1, b = chain >> 4, h = (chain >> 1) & 7, d = chain & 1;
    const _Float16* E = (const _Float16*)(p.ws + OFF_E16 + (size_t)d * SZ_M512_2); const _Float16* IC = (const _Float16*)(p.ws + OFF_IC16 + (size_t)d * SZ_M512_2);
    _Float16* Y = (_Float16*)(p.ws + OFF_Y16 + (size_t)d * SZ_M512_2);
    const int tl = tid - 256, ls = tl >> 3, j8 = (tl & 7) * 8; float ka[8];
    if (wid >= 4) ld8f(p.in[11] + h * 64 + j8, ka);
    auto load_chunk = [&](int c) { const int pos = scan_pos(d, c * SC_CH + ls); const size_t off = (size_t)(b * TPB + pos) * 512 + h * 64 + j8;
      float r[8], k[8], v[8], a[8], e[8], ic[8], w[8], bv[8], kd[8];
      ld8bf(R + off, r); ld8bf(Kk + off, k); ld8bf(V + off, v); ld8bf(NKK + off, a); ld8h(E + off, e); ld8h(IC + off, ic);
#pragma unroll
      for (int i = 0; i < 8; ++i) { w[i] = __builtin_amdgcn_exp2f(-1.4426950408889634f * e[i]); bv[i] = -a[i] * ic[i]; kd[i] = k[i] * (1.f + (ic[i] - 1.f) * ka[i]); }
      float* o = (float*)(ldsg + (c & 1) * SC_BUF) + ls * SC_STEP + j8;
      *(f32x4*)(o) = (f32x4){a[0], a[1], a[2], a[3]}; *(f32x4*)(o + 4) = (f32x4){a[4], a[5], a[6], a[7]};
      *(f32x4*)(o + 64) = (f32x4){w[0], w[1], w[2], w[3]}; *(f32x4*)(o + 68) = (f32x4){w[4], w[5], w[6], w[7]};
      *(f32x4*)(o + 128) = (f32x4){bv[0], bv[1], bv[2], bv[3]}; *(f32x4*)(o + 132) = (f32x4){bv[4], bv[5], bv[6], bv[7]};
      *(f32x4*)(o + 192) = (f32x4){kd[0], kd[1], kd[2], kd[3]}; *(f32x4*)(o + 196) = (f32x4){kd[4], kd[5], kd[6], kd[7]};
      *(f32x4*)(o + 256) = (f32x4){r[0], r[1], r[2], r[3]}; *(f32x4*)(o + 260) = (f32x4){r[4], r[5], r[6], r[7]};
      if ((j8 >> 5) == rh) { float* ov = (float*)(ldsg + (c & 1) * SC_BUF) + ls * SC_STEP + 320 + (j8 & 31);
        *(f32x4*)(ov) = (f32x4){v[0], v[1], v[2], v[3]}; *(f32x4*)(ov + 4) = (f32x4){v[4], v[5], v[6], v[7]}; } };
    auto flush_y = [&](int c) { const int pos = scan_pos(d, c * SC_CH + ls), r4 = (tl & 7) * 4; const f32x4 y = *(const f32x4*)(ybuf + (c & 1) * 1024 + ls * 32 + r4);
      *(h16x4*)(Y + (size_t)(b * TPB + pos) * 512 + h * 64 + rh * 32 + r4) = (h16x4){(_Float16)y[0], (_Float16)y[1], (_Float16)y[2], (_Float16)y[3]}; };
    const int rl = lane >> 3, jg = lane & 7; float S[8];
#pragma unroll
    for (int i = 0; i < 8; ++i) S[i] = 0.f;
    if (wid >= 4) load_chunk(0);
    __syncthreads();
    for (int c = 0; c < SC_NCH; ++c) {
      if (wid >= 4) { if (c + 1 < SC_NCH) load_chunk(c + 1); if (c >= 1) flush_y(c - 1); }
      else { const float* ob = (const float*)(ldsg + (c & 1) * SC_BUF) + jg * 8; float* yb = ybuf + (c & 1) * 1024 + wid * 8 + rl;
#pragma unroll 4
        for (int s = 0; s < SC_CH; ++s) { const float* o = ob + s * SC_STEP;
          const f32x4 a0 = *(const f32x4*)(o), a1 = *(const f32x4*)(o + 4), w0 = *(const f32x4*)(o + 64), w1 = *(const f32x4*)(o + 68), b0 = *(const f32x4*)(o + 128), b1 = *(const f32x4*)(o + 132),
                      k0 = *(const f32x4*)(o + 192), k1 = *(const f32x4*)(o + 196), r0 = *(const f32x4*)(o + 256), r1 = *(const f32x4*)(o + 260);
          const float v = ob[s * SC_STEP + 320 - jg * 8 + wid * 8 + rl];
          float sa = (S[0] * a0[0] + S[1] * a0[1]) + (S[2] * a0[2] + S[3] * a0[3]) + ((S[4] * a1[0] + S[5] * a1[1]) + (S[6] * a1[2] + S[7] * a1[3]));
          sa = red8(sa);
#pragma unroll
          for (int i = 0; i < 4; ++i) { S[i] = S[i] * w0[i] + (sa * b0[i] + v * k0[i]); S[4 + i] = S[4 + i] * w1[i] + (sa * b1[i] + v * k1[i]); }
          float y = (S[0] * r0[0] + S[1] * r0[1]) + (S[2] * r0[2] + S[3] * r0[3]) + ((S[4] * r1[0] + S[5] * r1[1]) + (S[6] * r1[2] + S[7] * r1[3]));
          y = red8(y);
          if (jg == 0) yb[s * 32] = y; } }
      __syncthreads();
    }
    if (wid >= 4) flush_y(SC_NCH - 1);
    __syncthreads();
  }
}

__device__ __forceinline__ void even_out_phase(const Params& p) {
  const int tid_ = opaque_tid(), wid = tid_ >> 6, lane = tid_ & 63, gw = blockIdx.x * 8 + wid, nw = gridDim.x * 8, ch = lane * 8;
  const bf16_t* CUG = (const bf16_t*)(p.ws + OFF_CUG); const bf16_t* ZB = (const bf16_t*)(p.ws + OFF_ZB); bf16_t* MIX = (bf16_t*)(p.ws + OFF_MIX);
  const bf16_t* R = (const bf16_t*)(p.ws + OFF_R); const bf16_t* Kk = (const bf16_t*)(p.ws + OFF_K); const bf16_t* V = (const bf16_t*)(p.ws + OFF_V);
  const _Float16* I0 = (const _Float16*)(p.ws + OFF_IC16); const _Float16* I1 = I0 + (size_t)MR * 512; const _Float16* Y0 = (const _Float16*)(p.ws + OFF_Y16); const _Float16* Y1 = Y0 + (size_t)MR * 512;
  float cw0[8], cw1[8], cw2[8], ka[8], rk[8], lw[8], lb[8];
  ld8f(p.in[8] + ch, cw0); ld8f(p.in[8] + 512 + ch, cw1); ld8f(p.in[8] + 1024 + ch, cw2); ld8f(p.in[11] + ch, ka); ld8f(p.in[16] + ch, rk); ld8f(p.in[17] + ch, lw); ld8f(p.in[18] + ch, lb);
  for (int g = gw; g < MR; g += nw) { const int pos = g % TPB; const bool hp = (pos != 0 && pos != CL), hn = (pos != CL - 1 && pos != TPB - 1);
    const bf16_t* cu = CUG + (size_t)g * 1024 + ch; float c[8], pv[8], nx[8], gg[8], o[8];
    ld8bf(cu, c); ld8bf(cu + 512, gg);
    if (hp) ld8bf(cu - 1024, pv); else {
#pragma unroll
      for (int i = 0; i < 8; ++i) pv[i] = 0.f; }
    if (hn) ld8bf(cu + 1024, nx); else {
#pragma unroll
      for (int i = 0; i < 8; ++i) nx[i] = 0.f; }
#pragma unroll
    for (int i = 0; i < 8; ++i) o[i] = gg[i] * (cw0[i] * pv[i] + cw1[i] * c[i] + cw2[i] * nx[i]);
    st8bf(MIX + (size_t)g * 1024 + ch, o);
    const size_t off = (size_t)g * 512 + ch; float y0[8], y1[8], r[8], k[8], v[8], i0[8], i1[8], zb[8];
    ld8h(Y0 + off, y0); ld8h(Y1 + off, y1); ld8bf(R + off, r); ld8bf(Kk + off, k); ld8bf(V + off, v); ld8h(I0 + off, i0); ld8h(I1 + off, i1); ld8bf(ZB + off, zb);
    float s = 0.f, t = 0.f;
#pragma unroll
    for (int i = 0; i < 8; ++i) { y0[i] += y1[i]; s += y0[i]; t += r[i] * k[i] * (2.f + (i0[i] + i1[i] - 2.f) * ka[i]) * rk[i]; }
    s = red8(s); t = red8(t); const float mean = s * (1.f / 64.f); float q = 0.f;
#pragma unroll
    for (int i = 0; i < 8; ++i) { y0[i] -= mean; q += y0[i] * y0[i]; }
    q = red8(q); const float rstd = rsqrtf(q * (1.f / 64.f) + 64e-5f);
#pragma unroll
    for (int i = 0; i < 8; ++i) o[i] = (y0[i] * rstd * lw[i] + lb[i] + t * v[i]) * zb[i];
    st8bf(MIX + (size_t)g * 1024 + 512 + ch, o); }
}

struct F6 { bf16_t* D0; const float* gate;
  __device__ __forceinline__ void operator()(int row, int pn, int c, f32x4 a0, f32x4 a1, f32x4 b0, f32x4 b1) const {
    const int b = row / TPB, pos = row - b * TPB, bb = pos < CL ? 8 : b; const float* gt = gate + bb * 3072 + 256 * pn + c; bf16_t* d = D0 + (size_t)row * 1024 + 256 * pn + c;
    st8(d, a0 * *(const f32x4*)gt, a1 * *(const f32x4*)(gt + 4)); st8(d + 128, b0 * *(const f32x4*)(gt + 128), b1 * *(const f32x4*)(gt + 132)); } };

struct F8 { bf16_t* P1S; bf16_t* Z;
  __device__ __forceinline__ void operator()(int row, int pn, int c, f32x4 a0, f32x4 a1, f32x4 b0, f32x4 b1) const {
    if (pn < 3) { bf16_t* d = P1S + (size_t)row * 768 + 256 * pn + c; st8(d, a0, a1); st8(d + 128, b0, b1); }
    else { bf16_t* d = Z + (size_t)row * 1024 + 256 * (pn - 3) + c; st8(d, silu4(a0), silu4(a1)); st8(d + 128, silu4(b0), silu4(b1)); } } };
struct FPlain { bf16_t* O; int ld;
  __device__ __forceinline__ void operator()(int row, int pn, int c, f32x4 a0, f32x4 a1, f32x4 b0, f32x4 b1) const { bf16_t* d = O + (size_t)row * ld + 256 * pn + c; st8(d, a0, a1); st8(d + 128, b0, b1); } };

__device__ __forceinline__ void rope8(float (&x)[8], int sub, int t) {
  const int axis = sub >> 2, half = (sub >> 1) & 1, p0 = (sub & 1) * 8; const float posv = (float)(axis ? (t & 63) : (t >> 6));
#pragma unroll
  for (int i = 0; i < 8; ++i) { const float other = __shfl_xor(x[i], 2); const float inv = exp2f(-(float)(p0 + i) * (13.287712379549449f / 16.f));
    float sn, cs; sincosf(posv * inv, &sn, &cs); x[i] = half ? (x[i] * cs + other * sn) : (x[i] * cs - other * sn); }
}
__device__ __forceinline__ void lat_norm_phase(const Params& p) {
  const int tid_ = opaque_tid(), wid = tid_ >> 6, lane = tid_ & 63, gw = blockIdx.x * 8 + wid, nw = gridDim.x * 8;
  const bf16_t* P1S = (const bf16_t*)(p.ws + OFF_P1S); bf16_t* QAN = (bf16_t*)(p.ws + OFF_QAN); bf16_t* KVAN = (bf16_t*)(p.ws + OFF_KVAN); bf16_t* KR = (bf16_t*)(p.ws + OFF_KROPE);
  for (int g = gw; g < MR; g += nw) { const int pos = g % TPB; const bf16_t* src = P1S + (size_t)g * 768; float q[8], kv[8], kr[8], w[8]; float s1 = 0.f, s2 = 0.f, s3 = 0.f;
#pragma unroll
    for (int i = 0; i < 8; ++i) { q[i] = 0.f; kv[i] = 0.f; kr[i] = 0.f; }
    if (lane < 48) ld8bf(src + lane * 8, q);
    if (lane < 32) ld8bf(src + 384 + lane * 8, kv);
    if (lane < 8) ld8bf(src + 640 + lane * 8, kr);
#pragma unroll
    for (int i = 0; i < 8; ++i) { s1 += q[i] * q[i]; s2 += kv[i] * kv[i]; s3 += kr[i] * kr[i]; }
    s1 = wave_sum(s1); s2 = wave_sum(s2); s3 = wave_sum(s3);
    const float r1 = rsqrtf(s1 * (1.f / 384.f) + 1e-6f), r2 = rsqrtf(s2 * (1.f / 256.f) + 1e-6f), r3 = rsqrtf(s3 * (1.f / 64.f) + 1e-6f);
    if (lane < 48) { ld8f(p.in[21] + lane * 8, w);
#pragma unroll
      for (int i = 0; i < 8; ++i) q[i] *= r1 * w[i];
      st8bf(QAN + (size_t)g * 384 + lane * 8, q); }
    if (lane < 32) { ld8f(p.in[22] + lane * 8, w);
#pragma unroll
      for (int i = 0; i < 8; ++i) kv[i] *= r2 * w[i];
      st8bf(KVAN + (size_t)g * 256 + lane * 8, kv); }
    { ld8f(p.in[28] + (lane & 7) * 8, w);
#pragma unroll
      for (int i = 0; i < 8; ++i) kr[i] *= r3 * w[i];
      if (pos >= CL) rope8(kr, lane & 7, pos - CL);
      if (lane < 8) st8bf(KR + (size_t)g * 64 + lane * 8, kr); } }
}
__device__ __forceinline__ void head_norm_phase(const Params& p) {
  const int tid_ = opaque_tid(), wid = tid_ >> 6, lane = tid_ & 63, gw = blockIdx.x * 8 + wid, nw = gridDim.x * 8, hd = lane >> 3, sub = lane & 7;
  bf16_t* QR = (bf16_t*)(p.ws + OFF_QRAW); bf16_t* KV = (bf16_t*)(p.ws + OFF_KVRAW);
  float gqn0[8], gqn1[8], gqr[8], gkn0[8], gkn1[8];
  ld8f(p.in[25] + sub * 16, gqn0); ld8f(p.in[25] + sub * 16 + 8, gqn1); ld8f(p.in[26] + sub * 8, gqr); ld8f(p.in[27] + sub * 16, gkn0); ld8f(p.in[27] + sub * 16 + 8, gkn1);
  for (int g = gw; g < MR; g += nw) { const int pos = g % TPB;
    { bf16_t* kp = KV + (size_t)g * 2048 + hd * 256 + sub * 16; float a[8], b[8]; ld8bf(kp, a); ld8bf(kp + 8, b); float s = 0.f;
#pragma unroll
      for (int i = 0; i < 8; ++i) s += a[i] * a[i] + b[i] * b[i];
      s = red8(s); const float rs = rsqrtf(s * (1.f / 128.f) + 1e-6f);
#pragma unroll
      for (int i = 0; i < 8; ++i) { a[i] *= rs * gkn0[i]; b[i] *= rs * gkn1[i]; }
      st8bf(kp, a); st8bf(kp + 8, b); }
    if (pos >= CL) { bf16_t* qp = QR + (size_t)g * 1536 + hd * 192; float a[8], b[8], r[8]; ld8bf(qp + sub * 16, a); ld8bf(qp + sub * 16 + 8, b); ld8bf(qp + 128 + sub * 8, r); float s = 0.f, s2 = 0.f;
#pragma unroll
      for (int i = 0; i < 8; ++i) { s += a[i] * a[i] + b[i] * b[i]; s2 += r[i] * r[i]; }
      s = red8(s); s2 = red8(s2); const float rs = rsqrtf(s * (1.f / 128.f) + 1e-6f) * SM_SCALE, rs2 = rsqrtf(s2 * (1.f / 64.f) + 1e-6f) * SM_SCALE;
#pragma unroll
      for (int i = 0; i < 8; ++i) { a[i] *= rs * gqn0[i]; b[i] *= rs * gqn1[i]; r[i] *= rs2 * gqr[i]; }
      rope8(r, sub, pos - CL);
      st8bf(qp + sub * 16, a); st8bf(qp + sub * 16 + 8, b); st8bf(qp + 128 + sub * 8, r); } }
}
struct F13 { float* out; const float* x; const bf16_t* D0; const float* gate;
  __device__ __forceinline__ void operator()(int row, int pn, int c, f32x4 a0, f32x4 a1, f32x4 b0, f32x4 b1) const {
    const int b = row / TPB, pos = row - b * TPB; if (pos < CL) return;
    const size_t o = (size_t)(b * SEQ + pos - CL) * 1024 + 256 * pn + c; const float* gt = gate + b * 3072 + 256 * pn + c; const bf16_t* d = D0 + (size_t)row * 1024 + 256 * pn + c;
    float d0[8], d1[8]; ld8bf(d, d0); ld8bf(d + 128, d1);
    const f32x4 x0 = *(const f32x4*)(x + o), x1 = *(const f32x4*)(x + o + 4), x2 = *(const f32x4*)(x + o + 128), x3 = *(const f32x4*)(x + o + 132);
    *(f32x4*)(out + o) = x0 + (f32x4){d0[0], d0[1], d0[2], d0[3]} + a0 * *(const f32x4*)gt;
    *(f32x4*)(out + o + 4) = x1 + (f32x4){d0[4], d0[5], d0[6], d0[7]} + a1 * *(const f32x4*)(gt + 4);
    *(f32x4*)(out + o + 128) = x2 + (f32x4){d1[0], d1[1], d1[2], d1[3]} + b0 * *(const f32x4*)(gt + 128);
    *(f32x4*)(out + o + 132) = x3 + (f32x4){d1[4], d1[5], d1[6], d1[7]} + b1 * *(const f32x4*)(gt + 132); } };

namespace att {
constexpr int NW = 8, QBLK = 32, KVBLK = 64, LDQ = 1536, LDK = 2048, LDKR = 64, LDO = 1024;
constexpr int SHM_V = KVBLK * 128 * 2, SHM_K = KVBLK * 128 * 2, SHM_KR = KVBLK * 64 * 2;
constexpr float THR = 8.f;
#define KSWZ(row, colB) ((row) * 256 + ((colB) ^ (((row) & 7) << 4)))
#define KRSWZ(row, colB) ((row) * 128 + ((colB) ^ (((row) & 7) << 4)))
#define SBAR() __builtin_amdgcn_sched_barrier(0)
__device__ __forceinline__ int crow(int r, int hi) { return (r & 3) + 8 * (r >> 2) + 4 * hi; }
__device__ __forceinline__ unsigned cvtpkv(float lo, float hi) { unsigned r; asm volatile("v_cvt_pk_bf16_f32 %0, %1, %2" : "=v"(r) : "v"(lo), "v"(hi)); return r; }
__device__ __forceinline__ void partialSM(f32x16& p0, f32x16& p1, float& m_reg, float& mn, float& alpha) {
  constexpr float C = 1.4426950408889634f;
  float pmax = p0[0];
#pragma unroll
  for (int r = 1; r < 16; ++r) pmax = fmaxf(pmax, p0[r]);
#pragma unroll
  for (int r = 0; r < 16; ++r) pmax = fmaxf(pmax, p1[r]);
  { auto rr = __builtin_amdgcn_permlane32_swap(__float_as_uint(pmax), __float_as_uint(pmax), false, false);
    pmax = fmaxf(__uint_as_float(rr[0]), __uint_as_float(rr[1])); }
  if (__builtin_expect(__all(pmax - m_reg <= THR), 1)) { mn = m_reg; alpha = 1.f; }
  else { mn = fmaxf(m_reg, pmax); alpha = __builtin_amdgcn_exp2f((m_reg - mn) * C); m_reg = mn; }
  const float mnC = -mn * C;
#pragma unroll
  for (int r = 0; r < 16; ++r) p0[r] = fmaf(p0[r], C, mnC);
#pragma unroll
  for (int r = 0; r < 16; ++r) p1[r] = fmaf(p1[r], C, mnC);
#pragma unroll
  for (int r = 0; r < 16; ++r) p0[r] = __builtin_amdgcn_exp2f(p0[r]);
}
__device__ __forceinline__ void finishSM(f32x16& p0, f32x16& p1, float alpha, float& l_reg, bf16x8& pa0, bf16x8& pa1, bf16x8& pa2, bf16x8& pa3) {
#pragma unroll
  for (int r = 0; r < 16; ++r) p1[r] = __builtin_amdgcn_exp2f(p1[r]);
  float ps = 0;
#pragma unroll
  for (int r = 0; r < 16; ++r) ps += p0[r];
#pragma unroll
  for (int r = 0; r < 16; ++r) ps += p1[r];
  { auto rr = __builtin_amdgcn_permlane32_swap(__float_as_uint(ps), __float_as_uint(ps), false, false);
    ps = __uint_as_float(rr[0]) + __uint_as_float(rr[1]); }
  l_reg = l_reg * alpha + ps;
#define PK4(P, BASE, OUT) do { unsigned a0 = cvtpkv(P[BASE + 0], P[BASE + 1]), a1 = cvtpkv(P[BASE + 2], P[BASE + 3]);   \
    unsigned b0 = cvtpkv(P[BASE + 4], P[BASE + 5]), b1 = cvtpkv(P[BASE + 6], P[BASE + 7]);                              \
    auto r0 = __builtin_amdgcn_permlane32_swap(a0, b0, false, false); auto r1 = __builtin_amdgcn_permlane32_swap(a1, b1, false, false); \
    u32x4 w = {r0[0], r1[0], r0[1], r1[1]}; OUT = *reinterpret_cast<bf16x8*>(&w); } while (0)
  PK4(p0, 0, pa0); PK4(p0, 8, pa1); PK4(p1, 0, pa2); PK4(p1, 8, pa3);
#undef PK4
}
__device__ __forceinline__ void qkt(f32x16& p0, f32x16& p1, const char* Ks, const char* KRs, const bf16x8* qr, int r32, int hi) {
  p0 = f32x16{}; p1 = f32x16{};
#pragma unroll
  for (int d0 = 0; d0 < 8; ++d0) { const int cb = (d0 * 16 + hi * 8) * 2;
    const bf16x8 b0 = *reinterpret_cast<const bf16x8*>(Ks + KSWZ(r32, cb));
    const bf16x8 b1 = *reinterpret_cast<const bf16x8*>(Ks + KSWZ(32 + r32, cb));
    p0 = __builtin_amdgcn_mfma_f32_32x32x16_bf16(b0, qr[d0], p0, 0, 0, 0);
    p1 = __builtin_amdgcn_mfma_f32_32x32x16_bf16(b1, qr[d0], p1, 0, 0, 0); }
#pragma unroll
  for (int d0 = 0; d0 < 4; ++d0) { const int cb = (d0 * 16 + hi * 8) * 2;
    const bf16x8 b0 = *reinterpret_cast<const bf16x8*>(KRs + KRSWZ(r32, cb));
    const bf16x8 b1 = *reinterpret_cast<const bf16x8*>(KRs + KRSWZ(32 + r32, cb));
    p0 = __builtin_amdgcn_mfma_f32_32x32x16_bf16(b0, qr[8 + d0], p0, 0, 0, 0);
    p1 = __builtin_amdgcn_mfma_f32_32x32x16_bf16(b1, qr[8 + d0], p1, 0, 0, 0); }
}
__device__ __forceinline__ int v_st(int k, int c) { const int kk = (k & ~0xC) | ((k & 4) << 1) | ((k & 8) >> 1); return ((kk >> 3) * 4 + (c >> 5)) * 512 + ((kk & 7) * 32 + (c & 31)) * 2; }
__device__ __forceinline__ int v_rd_base(int lane) { return ((lane & 3) << 3) | (((lane >> 2) & 3) << 6) | (((lane >> 4) & 1) << 5) | (((lane >> 5) & 1) << 8); }
constexpr int v_rd_off(int d0, int ks, int half) { return d0 * 512 + ks * 4096 + half * 2048; }
template <int OFF> __device__ __forceinline__ s16x4 tr_read(int vb) {
  s16x4 r; asm volatile("ds_read_b64_tr_b16 %0, %1 offset:%2" : "=&v"(r) : "v"(vb), "i"(OFF) : "memory"); return r;
}
template <int D0> __device__ __forceinline__ void pv_one(f32x16& od, int vb, bf16x8 pa0, bf16x8 pa1, bf16x8 pa2, bf16x8 pa3) {
  const s16x4 l0 = tr_read<v_rd_off(D0, 0, 0)>(vb), h0 = tr_read<v_rd_off(D0, 0, 1)>(vb), l1 = tr_read<v_rd_off(D0, 1, 0)>(vb), h1 = tr_read<v_rd_off(D0, 1, 1)>(vb);
  const s16x4 l2 = tr_read<v_rd_off(D0, 2, 0)>(vb), h2 = tr_read<v_rd_off(D0, 2, 1)>(vb), l3 = tr_read<v_rd_off(D0, 3, 0)>(vb), h3 = tr_read<v_rd_off(D0, 3, 1)>(vb);
  asm volatile("s_waitcnt lgkmcnt(0)" ::: "memory"); SBAR();
#define PK(L, H) (bf16x8){L[0], L[1], L[2], L[3], H[0], H[1], H[2], H[3]}
  od = __builtin_amdgcn_mfma_f32_32x32x16_bf16(pa0, PK(l0, h0), od, 0, 0, 0);
  od = __builtin_amdgcn_mfma_f32_32x32x16_bf16(pa1, PK(l1, h1), od, 0, 0, 0);
  od = __builtin_amdgcn_mfma_f32_32x32x16_bf16(pa2, PK(l2, h2), od, 0, 0, 0);
  od = __builtin_amdgcn_mfma_f32_32x32x16_bf16(pa3, PK(l3, h3), od, 0, 0, 0);
#undef PK
}
__device__ __forceinline__ void pv_d0(f32x16* o, int vb, bf16x8 pa0, bf16x8 pa1, bf16x8 pa2, bf16x8 pa3) {
  pv_one<0>(o[0], vb, pa0, pa1, pa2, pa3); pv_one<1>(o[1], vb, pa0, pa1, pa2, pa3); pv_one<2>(o[2], vb, pa0, pa1, pa2, pa3); pv_one<3>(o[3], vb, pa0, pa1, pa2, pa3);
}
__device__ __forceinline__ void attn_unit(const bf16_t* __restrict__ Qb, const bf16_t* __restrict__ Kh, const bf16_t* __restrict__ KRh, const bf16_t* __restrict__ Vh,
                                          const bf16_t* __restrict__ Zb, bf16_t* __restrict__ Ob, int seq, char* lds) {
  const int tid = opaque_tid(), wid = tid >> 6, lane = tid & 63, r32 = lane & 31, hi = lane >> 5;
  char* V_lds = lds; char* K_lds = lds + 2 * SHM_V; char* KR_lds = lds + 2 * SHM_V + 2 * SHM_K;
  float* ws = (float*)(lds + 2 * SHM_V + 2 * SHM_K + 2 * SHM_KR) + wid * 64; float* li_l = ws; float* al_l = ws + 32;
  float m_reg = -1e30f, l_reg = 0; f32x16 o[4] = {}; bf16x8 qr[12];
  const bf16_t* Qw = Qb + (long)(wid * QBLK + r32) * LDQ + hi * 8;
#pragma unroll
  for (int d0 = 0; d0 < 12; ++d0) qr[d0] = *reinterpret_cast<const bf16x8*>(Qw + d0 * 16);
  const int vb0 = (int)(uintptr_t)V_lds + v_rd_base(lane);
  PG8_LAS unsigned char* l3 = (PG8_LAS unsigned char*)lds; const int wu = __builtin_amdgcn_readfirstlane(wid);
  int offK[2], offV[2], offKR;
#pragma unroll
  for (int i = 0; i < 2; ++i) { const int q = (wid * 2 + i) * 1024 + lane * 16; const int row = q >> 8, colB = (q & 255) ^ ((row & 7) << 4); offK[i] = row * LDK + (colB >> 1);
    const int sub = q >> 9, within = q & 511, kk = (sub >> 2) * 8 + (within >> 6), c = (sub & 3) * 32 + ((within & 63) >> 1), k = (kk & ~0xC) | ((kk & 4) << 1) | ((kk & 8) >> 1); offV[i] = k * LDK + c; }
  { const int q = wid * 1024 + lane * 16; const int row = q >> 7, colB = (q & 127) ^ ((row & 7) << 4); offKR = row * LDKR + (colB >> 1); }
#define SDMA(b, k0) do { _Pragma("unroll") for (int _i = 0; _i < 2; ++_i) { \
      __builtin_amdgcn_global_load_lds((const unsigned*)(Kh + (long)(k0) * LDK + offK[_i]), (PG8_LAS unsigned*)(l3 + 2 * SHM_V + (b) * SHM_K + (wu * 2 + _i) * 1024), 16, 0, 0); \
      __builtin_amdgcn_global_load_lds((const unsigned*)(Vh + (long)(k0) * LDK + offV[_i]), (PG8_LAS unsigned*)(l3 + (b) * SHM_V + (wu * 2 + _i) * 1024), 16, 0, 0); } \
    __builtin_amdgcn_global_load_lds((const unsigned*)(KRh + (long)(k0) * LDKR + offKR), (PG8_LAS unsigned*)(l3 + 2 * SHM_V + 2 * SHM_K + (b) * SHM_KR + wu * 1024), 16, 0, 0); } while (0)
#define SWAIT() asm volatile("s_waitcnt vmcnt(0)" ::: "memory")
#define RESC(a) do { if (__any((a) < 1.f)) { if (hi == 0) al_l[r32] = (a); asm volatile("s_waitcnt lgkmcnt(0)" ::: "memory"); \
    _Pragma("unroll") for (int d = 0; d < 4; ++d) _Pragma("unroll") for (int r = 0; r < 16; ++r) o[d][r] *= al_l[crow(r, hi)]; } } while (0)
  f32x16 pA0, pA1; float mnA, alA; bf16x8 pa0, pa1, pa2, pa3; const int NT = seq / KVBLK;
  SDMA(0, 0); SWAIT(); __syncthreads();
  for (int j = 0; j < NT; ++j) { const int bsel = j & 1;
    if (j + 1 < NT) SDMA(bsel ^ 1, (j + 1) * KVBLK);
    SBAR(); qkt(pA0, pA1, K_lds + bsel * SHM_K, KR_lds + bsel * SHM_KR, qr, r32, hi);
    partialSM(pA0, pA1, m_reg, mnA, alA);
    RESC(alA);
    finishSM(pA0, pA1, alA, l_reg, pa0, pa1, pa2, pa3); SBAR();
    pv_d0(o, vb0 + bsel * SHM_V, pa0, pa1, pa2, pa3);
    SWAIT(); __syncthreads();
  }
  if (hi == 0) li_l[r32] = l_reg; asm volatile("s_waitcnt lgkmcnt(0)" ::: "memory");
  { bf16_t* Ot = (bf16_t*)(lds + wid * 8192);
#pragma unroll
    for (int r = 0; r < 16; ++r) { const int orow = crow(r, hi); const float rl = __builtin_amdgcn_rcpf(li_l[orow]);
#pragma unroll
      for (int d0 = 0; d0 < 4; ++d0) Ot[orow * 128 + d0 * 32 + r32] = (bf16_t)(cvtpk(o[d0][r] * rl, 0.f) & 0xffffu); }
    asm volatile("s_waitcnt lgkmcnt(0)" ::: "memory");
    bf16_t* Ow = Ob + (long)(wid * QBLK) * LDO; const bf16_t* Zw = Zb + (long)(wid * QBLK) * LDO;
#pragma unroll
    for (int i = 0; i < 8; ++i) { const int chunk = i * 64 + lane, row = chunk >> 4, c8 = (chunk & 15) * 8; float ov[8], zv[8];
      ld8bf(Ot + row * 128 + c8, ov); ld8bf(Zw + (long)row * LDO + c8, zv);
#pragma unroll
      for (int e = 0; e < 8; ++e) ov[e] *= zv[e];
      st8bf(Ow + (long)row * LDO + c8, ov); } }
  __syncthreads();
#undef SDMA
#undef SWAIT
#undef RESC
}
}

__device__ __forceinline__ void attn_phase(const Params& p, char* lds) {
  const bf16_t* QR = (const bf16_t*)(p.ws + OFF_QRAW); const bf16_t* KV = (const bf16_t*)(p.ws + OFF_KVRAW); const bf16_t* KR = (const bf16_t*)(p.ws + OFF_KROPE);
  const bf16_t* Z = (const bf16_t*)(p.ws + OFF_Z); bf16_t* OG = (bf16_t*)(p.ws + OFF_OG);
  const int G = gridDim.x, bx = blockIdx.x, vcu = (G % 8 == 0) ? (bx % 8) * (G / 8) + bx / 8 : bx;
  for (int u = vcu; u < NB * 8 * 16; u += G) { const int qb = u & 15, h = (u >> 4) & 7, b = u >> 7; const size_t g0 = (size_t)b * TPB, gq = g0 + CL + qb * 256;
    att::attn_unit(QR + gq * 1536 + h * 192, KV + g0 * 2048 + h * 256, KR + g0 * 64, KV + g0 * 2048 + h * 256 + 128, Z + gq * 1024 + h * 128, OG + gq * 1024 + h * 128, TPB, lds); }
}

constexpr int LDS_BYTES = 131072;
#ifndef PHMASK
#define PHMASK 0xFFFF
#endif
#define PH(k) ((PHMASK >> (k)) & 1)
__global__ void __launch_bounds__(512, 2) fwd_megakernel(Params p) {
  extern __shared__ __attribute__((aligned(16))) unsigned char lds[];
  cg::grid_group grid = cg::this_grid();
  PG8_LAS unsigned char* l3 = (PG8_LAS unsigned char*)lds;
  const float* mod = (const float*)(p.ws + OFF_MOD);
  if (PH(0)) {
  p0_prologue(p, lds);
  }
  grid.sync();
  if (PH(1)) {
  modnorm_phase(p, 0);
  }
  grid.sync();
  if (PH(2)) {
  { F0 f{(bf16_t*)(p.ws + OFF_CUG), (bf16_t*)(p.ws + OFF_RW), (bf16_t*)(p.ws + OFF_ZB)};
    run_gemm(l3, (const bf16_t*)(p.ws + OFF_H), (const bf16_t*)(p.ws + OFF_W0T), MR, 4352, 1024, f); }
  }
  grid.sync();
  if (PH(3)) {
  rwkv_prep_phase(p);
  }
  grid.sync();
  if (PH(4)) {
  { FL f{(_Float16*)(p.ws + OFF_E16), (_Float16*)(p.ws + OFF_E16 + SZ_M512_2), (_Float16*)(p.ws + OFF_IC16), (_Float16*)(p.ws + OFF_IC16 + SZ_M512_2), p.in[12], p.in[14]};
    run_gemm(l3, (const bf16_t*)(p.ws + OFF_LA), (const bf16_t*)(p.ws + OFF_WLT), MR, 2048, 256, f); }
  }
  grid.sync();
  if (PH(5)) {
  scan_phase(p, lds);
  }
  grid.sync();
  if (PH(6)) {
  even_out_phase(p);
  }
  grid.sync();
  if (PH(7)) {
  { F6 f{(bf16_t*)(p.ws + OFF_DELTA0), mod + 2048};
    run_gemm(l3, (const bf16_t*)(p.ws + OFF_MIX), (const bf16_t*)(p.ws + OFF_WOUT0T), MR, 1024, 1024, f); }
  }
  grid.sync();
  if (PH(8)) {
  modnorm_phase(p, 1);
  }
  grid.sync();
  if (PH(9)) {
  { F8 f{(bf16_t*)(p.ws + OFF_P1S), (bf16_t*)(p.ws + OFF_Z)};
    run_gemm(l3, (const bf16_t*)(p.ws + OFF_H1), (const bf16_t*)(p.ws + OFF_W1T), MR, 1792, 1024, f); }
  }
  grid.sync();
  if (PH(10)) {
  lat_norm_phase(p);
  }
  grid.sync();
  if (PH(11)) {
  { FPlain f{(bf16_t*)(p.ws + OFF_QRAW), 1536};
    run_gemm(l3, (const bf16_t*)(p.ws + OFF_QAN), (const bf16_t*)(p.ws + OFF_WQBT), MR, 1536, 384, f); }
  { FPlain f{(bf16_t*)(p.ws + OFF_KVRAW), 2048};
    run_gemm(l3, (const bf16_t*)(p.ws + OFF_KVAN), (const bf16_t*)(p.ws + OFF_WKVBT), MR, 2048, 256, f); }
  }
  grid.sync();
  if (PH(12)) {
  head_norm_phase(p);
  }
  grid.sync();
  if (PH(13)) {
  attn_phase(p, (char*)lds);
  }
  grid.sync();
  if (PH(14)) {
  { F13 f{p.out, p.in[0], (const bf16_t*)(p.ws + OFF_DELTA0), mod + 9 * 3072 + 2048};
    run_gemm(l3, (const bf16_t*)(p.ws + OFF_OG), (const bf16_t*)(p.ws + OFF_WOT), MR, 1024, 1024, f); }
  }
}

extern "C" void kernel_launch(void* const* d_in, const int* in_sizes, int n_in, void* d_out, int out_size, void* d_ws, size_t ws_size, hipStream_t stream) {
  static int grid_blocks = 0;
  if (grid_blocks == 0) {
    if (n_in != 30 || ws_size < WS_NEED || out_size != NB * SEQ * DM) { fprintf(stderr, "kernel_launch: unexpected shapes: n_in %d ws %zu (need %zu) out %d\n", n_in, ws_size, (size_t)WS_NEED, out_size); grid_blocks = -1; return; }
    int dev = 0, cus = 0, per_cu = 0;
    hipGetDevice(&dev); hipDeviceGetAttribute(&cus, hipDeviceAttributeMultiprocessorCount, dev);
    if (hipFuncSetAttribute((const void*)fwd_megakernel, hipFuncAttributeMaxDynamicSharedMemorySize, LDS_BYTES) != hipSuccess) { fprintf(stderr, "kernel_launch: hipFuncSetAttribute failed\n"); grid_blocks = -1; return; }
    hipOccupancyMaxActiveBlocksPerMultiprocessor(&per_cu, (const void*)fwd_megakernel, 512, LDS_BYTES);
    if (per_cu < 1) { fprintf(stderr, "kernel_launch: occupancy query says %d blocks/CU\n", per_cu); per_cu = 1; }
    grid_blocks = cus * 1;
    (void)hipGetLastError();
  }
  if (grid_blocks < 0) return;
  Params p{};
  for (int i = 0; i < 30; ++i) p.in[i] = (const float*)d_in[i];
  p.out = (float*)d_out; p.ws = (unsigned char*)d_ws;
  void* args[] = {&p};
  hipError_t e = hipLaunchCooperativeKernel((const void*)fwd_megakernel, dim3(grid_blocks), dim3(512), args, LDS_BYTES, stream);
  if (e != hipSuccess) fprintf(stderr, "cooperative launch failed: %s (grid %d)\n", hipGetErrorString(e), grid_blocks);
}
```

```cpp
#include <hip/hip_runtime.h>
#include <hip/hip_cooperative_groups.h>
#include <cstdio>
namespace cg = cooperative_groups;
__device__ __forceinline__ int opaque_tid() { int t = threadIdx.x; asm volatile("" : "+v"(t)); return t; }
namespace pg8 {
#define PG8_LAS __attribute__((address_space(3)))
typedef unsigned short bf16_t;
typedef short bf16x8 __attribute__((ext_vector_type(8)));
typedef float f32x4 __attribute__((ext_vector_type(4)));
typedef unsigned u32x4 __attribute__((ext_vector_type(4)));
constexpr int BM = 256, BK = 64, HALF = 128, HTB = HALF * BK * 2  , STAGE_BYTES = 8 * HTB, NXCD = 8, WGM = 8;

__host__ __device__ __forceinline__ int lds_byte(int r, int c) { const int st = (r >> 4) * 2 + (c >> 5), rr = r & 15, cc = c & 31, ob = rr * 64 + cc * 2; return st * 1024 + (ob ^ (((ob >> 9) & 1) << 5)); }
__host__ __device__ __forceinline__ void stage_rc(int b, int& R, int& C) { const int st = b / 1024, sb = b % 1024, swz = sb ^ (((sb >> 9) & 1) << 5); R = (st >> 1) * 16 + swz / 64; C = (st & 1) * 32 + (swz % 64) / 2; }
__host__ __device__ __forceinline__ int perm32(int rho) { const int n = rho >> 4, i = rho & 15; return 8 * (i >> 2) + 4 * n + (i & 3); }

struct Unit { int pm, pn; };
struct Gemm { const bf16_t* A; const bf16_t* Bt; int M, N, K; };

struct StaticOrder {
    int nM, nN, nwg, G, c;
    __host__ __device__ void init(int M, int N, int G_, int c_) { nM = M / BM; nN = N / BM; nwg = nM * nN; G = G_; c = c_; }
    __host__ __device__ bool next(int i, Unit& u) const {
        const long L = (long)i * G + c; if (L >= nwg) return false;
        int wgid = (int)L; { const int q = nwg / NXCD, r = nwg % NXCD, xcd = wgid % NXCD, off = wgid / NXCD; wgid = (xcd < r ? xcd * (q + 1) : r * (q + 1) + (xcd - r) * q) + off; }
        const int nig = WGM * nN, gid = wgid / nig, fm = gid * WGM, gsz = (nM - fm) < WGM ? (nM - fm) : WGM;
        u.pm = fm + ((wgid % nig) % gsz); u.pn = (wgid % nig) / gsz; return true;
    }
    __device__ __forceinline__ void a_ready(const Unit&) const {}
    __device__ __forceinline__ void done(const Unit&) const {}
};
struct CountedOrder : StaticOrder {
    const unsigned* ready; unsigned need; unsigned* tmo;
    __device__ __forceinline__ void a_ready(const Unit& u) const {
        if (threadIdx.x < 64) {
            const unsigned long long t0 = __builtin_amdgcn_s_memrealtime(); unsigned polls = 0;
            while ((unsigned)__builtin_amdgcn_readfirstlane(__hip_atomic_load(ready + 64 * u.pm, __ATOMIC_RELAXED, __HIP_MEMORY_SCOPE_AGENT)) < need) {
                if ((++polls & 255u) == 0u && __builtin_amdgcn_readfirstlane(__hip_atomic_load(tmo, __ATOMIC_RELAXED, __HIP_MEMORY_SCOPE_AGENT)) != 0u) break;
                if (__builtin_amdgcn_s_memrealtime() - t0 > 2000000ull) {
                    if (threadIdx.x == 0) { unsigned expect = 0u; __hip_atomic_compare_exchange_strong(tmo + 1, &expect, 0x600u | (unsigned)(u.pm & 0xff), __ATOMIC_RELAXED, __ATOMIC_RELAXED, __HIP_MEMORY_SCOPE_AGENT); __hip_atomic_store(tmo, 1u, __ATOMIC_RELAXED, __HIP_MEMORY_SCOPE_AGENT); }
                    break; }
                __builtin_amdgcn_s_sleep(2); }
            __builtin_amdgcn_fence(__ATOMIC_ACQUIRE, "agent");
            asm volatile("s_waitcnt vmcnt(0)" ::: "memory");
        }
#if !defined(BROKEN_HOOK_NO_BARRIER)
        asm volatile("" ::: "memory"); __builtin_amdgcn_s_barrier(); asm volatile("" ::: "memory");
#endif
    }
};

__device__ __forceinline__ unsigned cvt_pk_bf16(float lo, float hi) { unsigned r; asm volatile("v_cvt_pk_bf16_f32 %0, %1, %2" : "=v"(r) : "v"(lo), "v"(hi)); return r; }
typedef float f32x2 __attribute__((ext_vector_type(2)));
__device__ __forceinline__ f32x2 gelu_pk(f32x2 v) {
    const f32x2 av = __builtin_elementwise_abs(v), d = av * 0.2316418882f + 1.0f;
    f32x2 t; t.x = __builtin_amdgcn_rcpf(d.x); t.y = __builtin_amdgcn_rcpf(d.y);
    f32x2 q = t * 0.5307027145f + (-0.7265760135f); q = q * t + 0.7107068705f; q = q * t + (-0.142248368f); q = q * t + 0.127414796f; q = q * t;
    const f32x2 s = (v * v) * (-0.72134752044f);
    f32x2 e; e.x = __builtin_amdgcn_exp2f(s.x); e.y = __builtin_amdgcn_exp2f(s.y);
    const f32x2 m = v * (q * e), r = v - m;
    f32x2 o; o.x = v.x < 0.f ? m.x : r.x; o.y = v.y < 0.f ? m.y : r.y; return o;
}

struct EpiF32 {
    static constexpr bool PERM = false, AFTER_DRAIN = false;
    float* C; int ldc; const float* bias;
    __device__ __forceinline__ void operator()(const f32x4 (&acc)[2][2][4][2], const Unit& u, int wr, int wc, int fr, int fq) const {
        const int row0 = u.pm * BM + wr * 64 + fr, col0 = u.pn * BM + wc * 32 + 4 * fq;
        f32x4 bv[2][2];
#pragma unroll
        for (int bj = 0; bj < 2; ++bj)
#pragma unroll
            for (int n = 0; n < 2; ++n) bv[bj][n] = bias ? *(const f32x4*)(bias + col0 + bj * HALF + n * 16) : (f32x4){0.f, 0.f, 0.f, 0.f};
#pragma unroll
        for (int ai = 0; ai < 2; ++ai)
#pragma unroll
            for (int m = 0; m < 4; ++m) { float* rowp = C + (size_t)(row0 + ai * HALF + m * 16) * ldc + col0;
#pragma unroll
                for (int bj = 0; bj < 2; ++bj)
#pragma unroll
                    for (int n = 0; n < 2; ++n) *(f32x4*)(rowp + bj * HALF + n * 16) = acc[ai][bj][m][n] + bv[bj][n]; }
    }
};
template <int ACT  > struct EpiBf16 {
    static constexpr bool PERM = true, AFTER_DRAIN = false;
    bf16_t* O; int ldc; const float* bias; int split_cols; size_t split_stride;
    __device__ __forceinline__ void operator()(const f32x4 (&acc)[2][2][4][2], const Unit& u, int wr, int wc, int fr, int fq) const {
        const int row0 = u.pm * BM + wr * 64 + fr; int colt = u.pn * BM; bf16_t* base = O;
        if (split_cols) { const int t = colt / split_cols; base += (size_t)t * split_stride; colt -= t * split_cols; }
        const int col0 = colt + wc * 32 + 8 * fq, bcol0 = u.pn * BM + wc * 32 + 8 * fq;
        f32x4 bv[2][2];
#pragma unroll
        for (int bj = 0; bj < 2; ++bj)
#pragma unroll
            for (int n = 0; n < 2; ++n) bv[bj][n] = bias ? *(const f32x4*)(bias + bcol0 + bj * HALF + 4 * n) : (f32x4){0.f, 0.f, 0.f, 0.f};
#pragma unroll
        for (int ai = 0; ai < 2; ++ai)
#pragma unroll
            for (int m = 0; m < 4; ++m) { bf16_t* rowp = base + (size_t)(row0 + ai * HALF + m * 16) * ldc + col0;
#pragma unroll
                for (int bj = 0; bj < 2; ++bj) { f32x4 v0 = acc[ai][bj][m][0] + bv[bj][0], v1 = acc[ai][bj][m][1] + bv[bj][1];
                    if (ACT == 1) { f32x2 a = gelu_pk((f32x2){v0[0], v0[1]}), b = gelu_pk((f32x2){v0[2], v0[3]}), c = gelu_pk((f32x2){v1[0], v1[1]}), d = gelu_pk((f32x2){v1[2], v1[3]});
                        v0 = (f32x4){a.x, a.y, b.x, b.y}; v1 = (f32x4){c.x, c.y, d.x, d.y}; }
                    if (ACT == 2) {
#pragma unroll
                        for (int j = 0; j < 4; ++j) { v0[j] = 0.5f * v0[j] * (1.0f + erff(v0[j] * 0.70710678f)); v1[j] = 0.5f * v1[j] * (1.0f + erff(v1[j] * 0.70710678f)); } }
                    u32x4 w; w.x = cvt_pk_bf16(v0[0], v0[1]); w.y = cvt_pk_bf16(v0[2], v0[3]); w.z = cvt_pk_bf16(v1[0], v1[1]); w.w = cvt_pk_bf16(v1[2], v1[3]);
                    *(u32x4*)(rowp + bj * HALF) = w; } }
    }
};

template <class Epi, class Sched, bool STAMP = false>
__device__ __forceinline__ void gemm_phase(PG8_LAS unsigned char* lds, const Gemm g, const Sched& S, const Epi& E, unsigned long long* stamps) {
    const int tid = opaque_tid(), wid = __builtin_amdgcn_readfirstlane(tid >> 6), lane = tid & 63, wr = wid >> 2, wc = wid & 3, fr = lane & 15, fq = lane >> 4;
    const int K = g.K, nt = K / BK;
    int ts_lo = 0, ts_hi = 0, nts = 0; const unsigned long long rt_entry = STAMP ? (unsigned long long)wall_clock64() : 0ull;
#define PG8_STAMP() do { if (STAMP && wid == 0 && nts < 64) { const unsigned long long _c = (unsigned long long)clock64(); \
        ts_lo = (lane == nts) ? (int)(unsigned)_c : ts_lo; ts_hi = (lane == nts) ? (int)(unsigned)(_c >> 32) : ts_hi; ++nts; } } while (0)
    PG8_STAMP();
    unsigned voffA[2], voffB[2];
#pragma unroll
    for (int i = 0; i < 2; ++i) { int R, C; stage_rc(tid * 16 + i * 8192, R, C); const int Rb = Epi::PERM ? ((R & ~31) + perm32(R & 31)) : R;
        voffA[i] = (unsigned)(R * K + C) * 2u; voffB[i] = (unsigned)(Rb * K + C) * 2u; }
    const size_t kstep = (size_t)(BK * 2);
    const size_t hstep = (size_t)HALF * K * 2;
    const size_t tstep = 2 * hstep;
    const unsigned ldsw = (unsigned)wid * 1024u;
    const int aoff = lds_byte(wr * 64 + fr, fq * 8), boff = lds_byte(wc * 32 + fr, fq * 8);
#define PG8_SA(b, h) (((b) * 2 + (h)) * HTB)
#define PG8_SB(b, h) ((4 + (b) * 2 + (h)) * HTB)
#define PG8_STAGE(bufoff, gbase, voff) do { _Pragma("unroll") for (int _i = 0; _i < 2; ++_i) \
        __builtin_amdgcn_global_load_lds((const unsigned*)((const char*)(gbase) + (voff)[_i]), (PG8_LAS unsigned*)(lds + (bufoff) + ldsw + _i * 8192), 16, 0, 0); } while (0)
#define PG8_LDA(dst, b, h) do { _Pragma("unroll") for (int m = 0; m < 4; ++m) _Pragma("unroll") for (int k = 0; k < 2; ++k) dst[m][k] = *(const PG8_LAS bf16x8*)(lds + PG8_SA(b, h) + aoff + m * 2048 + k * 1024); } while (0)
#define PG8_LDB(dst, b, h) do { _Pragma("unroll") for (int n = 0; n < 2; ++n) _Pragma("unroll") for (int k = 0; k < 2; ++k) dst[n][k] = *(const PG8_LAS bf16x8*)(lds + PG8_SB(b, h) + boff + n * 2048 + k * 1024); } while (0)
#define PG8_MMA(ai, bj, At, Bt) do { __builtin_amdgcn_s_setprio(1); _Pragma("unroll") for (int m = 0; m < 4; ++m) _Pragma("unroll") for (int n = 0; n < 2; ++n) _Pragma("unroll") for (int k = 0; k < 2; ++k) \
        acc[ai][bj][m][n] = __builtin_amdgcn_mfma_f32_16x16x32_bf16(Bt[n][k], At[m][k], acc[ai][bj][m][n], 0, 0, 0); __builtin_amdgcn_s_setprio(0); } while (0)
#define PG8_WAIT_V(n) asm volatile("s_waitcnt vmcnt(" #n ")" ::: "memory")
#define PG8_WAIT_L(n) asm volatile("s_waitcnt lgkmcnt(" #n ")" ::: "memory")
#define PG8_BAR __builtin_amdgcn_s_barrier()
#define PG8_SCHED __builtin_amdgcn_sched_barrier(0)
    Unit cur, nxt; int ui = 0;
    if (!S.next(0, cur)) return;
    f32x4 acc[2][2][4][2];
#pragma unroll
    for (int a = 0; a < 2; ++a)
#pragma unroll
        for (int b = 0; b < 2; ++b)
#pragma unroll
            for (int m = 0; m < 4; ++m)
#pragma unroll
                for (int n = 0; n < 2; ++n) acc[a][b][m][n] = (f32x4){0.f, 0.f, 0.f, 0.f};
    bf16x8 At[4][2], B0[2][2], B1[2][2];
    const char* cA = (const char*)g.A + (size_t)cur.pm * tstep; const char* cB = (const char*)g.Bt + (size_t)cur.pn * tstep;
    S.a_ready(cur);
    PG8_STAGE(PG8_SB(0, 0), cB, voffB); PG8_STAGE(PG8_SA(0, 0), cA, voffA); PG8_STAGE(PG8_SB(0, 1), cB + hstep, voffB); PG8_STAGE(PG8_SA(0, 1), cA + hstep, voffA);
    if (wr == 1) PG8_BAR;
    PG8_WAIT_V(4); PG8_BAR;
    PG8_STAGE(PG8_SB(1, 0), cB + kstep, voffB); PG8_STAGE(PG8_SA(1, 0), cA + kstep, voffA); PG8_STAGE(PG8_SB(1, 1), cB + hstep + kstep, voffB);
    PG8_WAIT_V(6); PG8_BAR;
    PG8_STAMP();
    for (;;) {
        const bool has_next = S.next(ui + 1, nxt);
        const char* nA = has_next ? (const char*)g.A + (size_t)nxt.pm * tstep : cA; const char* nB = has_next ? (const char*)g.Bt + (size_t)nxt.pn * tstep : cB;
#pragma unroll 1
        for (int t = 0; t < nt; t += 2) {
            const bool last = (t == nt - 2);
            const char* a1 = cA + (size_t)(t + 1) * kstep;
            const char* a2 = last ? nA : cA + (size_t)(t + 2) * kstep; const char* b2 = last ? nB : cB + (size_t)(t + 2) * kstep;
            const char* a3 = a2 + kstep; const char* b3 = b2 + kstep;
            if (last && has_next) S.a_ready(nxt);
            PG8_LDB(B0, 0, 0); PG8_SCHED; PG8_LDA(At, 0, 0); PG8_STAGE(PG8_SA(1, 1), a1 + hstep, voffA);
            PG8_WAIT_L(8); PG8_BAR; PG8_WAIT_L(0); PG8_MMA(0, 0, At, B0); PG8_BAR; PG8_SCHED;
            PG8_LDB(B1, 0, 1); PG8_STAGE(PG8_SB(0, 0), b2, voffB);
            PG8_BAR; PG8_WAIT_L(0); PG8_MMA(0, 1, At, B1); PG8_BAR;
            PG8_LDA(At, 0, 1); PG8_STAGE(PG8_SA(0, 0), a2, voffA);
            PG8_BAR; PG8_WAIT_L(0); PG8_MMA(1, 0, At, B0); PG8_BAR; PG8_SCHED;
            PG8_STAGE(PG8_SB(0, 1), b2 + hstep, voffB);
            PG8_WAIT_V(6); PG8_BAR; PG8_MMA(1, 1, At, B1); PG8_BAR;
            PG8_LDB(B0, 1, 0); PG8_SCHED; PG8_LDA(At, 1, 0); PG8_STAGE(PG8_SA(0, 1), a2 + hstep, voffA);
            PG8_WAIT_L(8); PG8_BAR; PG8_WAIT_L(0); PG8_MMA(0, 0, At, B0); PG8_BAR; PG8_SCHED;
            PG8_LDB(B1, 1, 1); PG8_STAGE(PG8_SB(1, 0), b3, voffB);
            PG8_BAR; PG8_WAIT_L(0); PG8_MMA(0, 1, At, B1); PG8_BAR;
            PG8_LDA(At, 1, 1); PG8_STAGE(PG8_SA(1, 0), a3, voffA);
            PG8_BAR; PG8_WAIT_L(0); PG8_MMA(1, 0, At, B0); PG8_BAR; PG8_SCHED;
            PG8_STAGE(PG8_SB(1, 1), b3 + hstep, voffB);
            PG8_WAIT_V(6); PG8_BAR; PG8_MMA(1, 1, At, B1); PG8_BAR;
        }
        PG8_STAMP();
        if constexpr (!Epi::AFTER_DRAIN) { E(acc, cur, wr, wc, fr, fq); S.done(cur); }
        PG8_STAMP();
        if (!has_next) break;
#pragma unroll
        for (int a = 0; a < 2; ++a)
#pragma unroll
            for (int b = 0; b < 2; ++b)
#pragma unroll
                for (int m = 0; m < 4; ++m)
#pragma unroll
                    for (int n = 0; n < 2; ++n) acc[a][b][m][n] = (f32x4){0.f, 0.f, 0.f, 0.f};
        cur = nxt; cA = nA; cB = nB; ++ui;
    }
    PG8_WAIT_V(0);
    if (wr == 0) PG8_BAR;
    PG8_BAR;
    if constexpr (Epi::AFTER_DRAIN) { E.fused(acc, cur, wr, wc, fr, fq, lds, wid, lane); S.done(cur); }
    PG8_STAMP();
    if (STAMP && wid == 0) { stamps[lane] = lane < nts ? (((unsigned long long)(unsigned)ts_hi << 32) | (unsigned)ts_lo) : 0ull;
        if (lane == 62) stamps[62] = rt_entry; if (lane == 63) stamps[63] = (unsigned long long)wall_clock64(); }
#undef PG8_STAMP
#undef PG8_SA
#undef PG8_SB
#undef PG8_STAGE
#undef PG8_LDA
#undef PG8_LDB
#undef PG8_MMA
#undef PG8_WAIT_V
#undef PG8_WAIT_L
#undef PG8_BAR
#undef PG8_SCHED
}
}

typedef unsigned short bf16_t;
typedef short bf16x8 __attribute__((ext_vector_type(8)));
typedef short s16x4 __attribute__((ext_vector_type(4)));
typedef float f32x4 __attribute__((ext_vector_type(4)));
typedef float f32x16 __attribute__((ext_vector_type(16)));
typedef unsigned u32x4 __attribute__((ext_vector_type(4)));
typedef unsigned u32x2 __attribute__((ext_vector_type(2)));
typedef float f32x2 __attribute__((ext_vector_type(2)));
typedef _Float16 h16x8 __attribute__((ext_vector_type(8)));
typedef _Float16 h16x4 __attribute__((ext_vector_type(4)));

constexpr int NB = 8, SEQ = 4096, CL = 256, DM = 1024, TPB = 4352  , MR = NB * TPB  ;
constexpr float SM_SCALE = 0.07216878364870322f;

constexpr size_t OFF_W0T = 0, OFF_WLT = 8912896, OFF_WOUT0T = 9961472, OFF_W1T = 12058624, OFF_WQBT = 15728640, OFF_WKVBT = 16908288, OFF_WOT = 17956864,
                 OFF_MOD = 20054016, OFF_R1 = 20275200;
constexpr size_t SZ_M512_2 = (size_t)MR * 512 * 2  , SZ_M1024_2 = (size_t)MR * 1024 * 2  ;
constexpr size_t OFF_H = OFF_R1, OFF_E16 = OFF_R1  , OFF_MIX = OFF_R1 + SZ_M1024_2, OFF_DELTA0 = OFF_R1;
constexpr size_t OFF_R2 = OFF_R1 + (size_t)MR * 1024 * 4  , OFF_RW = OFF_R2  ;
constexpr size_t OFF_R3 = OFF_R2 + (size_t)MR * 1664 * 2, OFF_CUG = OFF_R3, OFF_ZB = OFF_R3 + SZ_M1024_2;
constexpr size_t OFF_R4 = OFF_R3 + SZ_M1024_2 + SZ_M512_2, OFF_IC16 = OFF_R4  ;
constexpr size_t OFF_R5 = OFF_R4 + SZ_M1024_2, OFF_Y16 = OFF_R5  , OFF_LA = OFF_R4  ;
constexpr size_t WS_NEED0 = OFF_R5 + SZ_M1024_2;
constexpr size_t OFF_H1 = OFF_R1 + SZ_M1024_2, OFF_QAN = OFF_H1, OFF_OG = OFF_H1;
constexpr size_t OFF_Z = OFF_R2, OFF_P1S = OFF_R2 + SZ_M1024_2  , OFF_QRAW = OFF_P1S + (size_t)MR * 384 * 2  , OFF_KVRAW = OFF_QRAW + (size_t)MR * 1536 * 2, OFF_KROPE = OFF_KVRAW + (size_t)MR * 2048 * 2;
constexpr size_t OFF_KVAN = OFF_KROPE + (size_t)MR * 64 * 2;
constexpr size_t OFF_SSQ = OFF_KVAN + (size_t)MR * 256 * 2;
constexpr size_t WS_NEED1 = OFF_SSQ + (size_t)MR * 4;
constexpr size_t OFF_BAR = WS_NEED0 > WS_NEED1 ? WS_NEED0 : WS_NEED1;
constexpr size_t BAR_BYTES = 16384;
constexpr size_t OFF_ROPE = OFF_BAR + BAR_BYTES;
constexpr size_t OFF_TS = OFF_ROPE + 8192;
constexpr size_t WS_NEED = OFF_TS + (size_t)2 * MR * 8 * 4;
static_assert(WS_NEED <= 536870912, "workspace2");
static_assert(WS_NEED <= 536870912, "workspace");
static_assert(OFF_R1 % 256 == 0 && OFF_R2 % 256 == 0 && OFF_R3 % 256 == 0, "align");

struct Params { const float* in[30]; float* out; unsigned char* ws; };

__device__ __forceinline__ unsigned cvtpk(float lo, float hi) { unsigned r; asm("v_cvt_pk_bf16_f32 %0, %1, %2" : "=v"(r) : "v"(lo), "v"(hi)); return r; }
__device__ __forceinline__ u32x4 pack8(const float (&v)[8]) { return (u32x4){cvtpk(v[0], v[1]), cvtpk(v[2], v[3]), cvtpk(v[4], v[5]), cvtpk(v[6], v[7])}; }
__device__ __forceinline__ void unpack8(u32x4 w, float (&v)[8]) {
  v[0] = __uint_as_float(w.x << 16); v[1] = __uint_as_float(w.x & 0xffff0000u); v[2] = __uint_as_float(w.y << 16); v[3] = __uint_as_float(w.y & 0xffff0000u);
  v[4] = __uint_as_float(w.z << 16); v[5] = __uint_as_float(w.z & 0xffff0000u); v[6] = __uint_as_float(w.w << 16); v[7] = __uint_as_float(w.w & 0xffff0000u); }
__device__ __forceinline__ void ld8bf(const bf16_t* p, float (&v)[8]) { unpack8(*(const u32x4*)p, v); }
__device__ __forceinline__ void st8bf(bf16_t* p, const float (&v)[8]) { *(u32x4*)p = pack8(v); }
__device__ __forceinline__ void ld8f(const float* p, float (&v)[8]) { const f32x4 a = *(const f32x4*)p, b = *(const f32x4*)(p + 4); v[0] = a[0]; v[1] = a[1]; v[2] = a[2]; v[3] = a[3]; v[4] = b[0]; v[5] = b[1]; v[6] = b[2]; v[7] = b[3]; }
__device__ __forceinline__ void ld8h(const _Float16* p, float (&v)[8]) { const h16x8 a = *(const h16x8*)p;
#pragma unroll
  for (int i = 0; i < 8; ++i) v[i] = (float)a[i]; }
__device__ __forceinline__ float sigmoidf_(float x) { return __builtin_amdgcn_rcpf(1.f + __expf(-x)); }
__device__ __forceinline__ float siluf_(float x) { return x * sigmoidf_(x); }
__device__ __forceinline__ f32x4 silu4(f32x4 x) { return (f32x4){siluf_(x[0]), siluf_(x[1]), siluf_(x[2]), siluf_(x[3])}; }
__device__ __forceinline__ void st8(bf16_t* d, f32x4 a, f32x4 b) { *(u32x4*)d = (u32x4){cvtpk(a[0], a[1]), cvtpk(a[2], a[3]), cvtpk(b[0], b[1]), cvtpk(b[2], b[3])}; }
template <int CTRL> __device__ __forceinline__ float dppmov(float v) { return __int_as_float(__builtin_amdgcn_update_dpp(0, __float_as_int(v), CTRL, 0xF, 0xF, true)); }
__device__ __forceinline__ float red8(float x) { x += dppmov<0xB1>(x); x += dppmov<0x4E>(x); x += dppmov<0x141>(x); return x; }
__device__ __forceinline__ float wave_sum(float x) {
#pragma unroll
  for (int o = 32; o >= 1; o >>= 1) x += __shfl_xor(x, o);
  return x; }

template <class F> struct EpiT { static constexpr bool PERM = true, AFTER_DRAIN = false; F f;
  __device__ __forceinline__ void operator()(const f32x4 (&acc)[2][2][4][2], const pg8::Unit& u, int wr, int wc, int fr, int fq) const {
    const int c = wc * 32 + 8 * fq;
#pragma unroll
    for (int ai = 0; ai < 2; ++ai)
#pragma unroll
      for (int m = 0; m < 4; ++m) { const int row = u.pm * 256 + ai * 128 + wr * 64 + m * 16 + fr;
        f(row, u.pn, c, acc[ai][0][m][0], acc[ai][0][m][1], acc[ai][1][m][0], acc[ai][1][m][1]); } } };

struct LatOrder : pg8::StaticOrder {
  __device__ bool next(int i, pg8::Unit& u) const { const bool ok = pg8::StaticOrder::next(i, u); u.pm = (u.pm >> 4) * 17 + 1 + (u.pm & 15); return ok; } };
template <class F> __device__ __forceinline__ void run_gemm_lat(PG8_LAS unsigned char* lds, const bf16_t* A, const bf16_t* Bt, int N_, int K_, const F& f) {
  pg8::Gemm g{A, Bt, MR, N_, K_}; LatOrder S; S.init(NB * SEQ, N_, (int)gridDim.x, (int)blockIdx.x);
  EpiT<F> E{f};
  pg8::gemm_phase<EpiT<F>, LatOrder, false>(lds, g, S, E, nullptr);
}
template <class F> __device__ __forceinline__ void run_gemm(PG8_LAS unsigned char* lds, const bf16_t* A, const bf16_t* Bt, int M_, int N_, int K_, const F& f) {
  pg8::Gemm g{A, Bt, M_, N_, K_}; pg8::StaticOrder S; S.init(M_, N_, (int)gridDim.x, (int)blockIdx.x);
  EpiT<F> E{f};
  pg8::gemm_phase<EpiT<F>, pg8::StaticOrder, false>(lds, g, S, E, nullptr);
}

template <class MapF> __device__ __forceinline__ void transpose_w(const float* __restrict__ W, int K, int N, bf16_t* __restrict__ Wt, int Nout, MapF map, int gtid, int gn) {
  const int total = Nout * (K / 8);
#pragma unroll 4
  for (int q = gtid; q < total; q += gn) { const int n = q % Nout, k8 = q / Nout; const int src = map(n); float v[8];
#pragma unroll
    for (int i = 0; i < 8; ++i) v[i] = src >= 0 ? W[(size_t)(k8 * 8 + i) * N + src] : 0.f;
    st8bf(Wt + (size_t)n * K + k8 * 8, v); }
}
__device__ __forceinline__ int wsrc_col(int id, int n) {
  if (id == 0) { const int pn = n >> 8, c = n & 255, half = c >> 7, ci = c & 127;
    if (pn < 4) return half ? 1024 + 128 * pn + ci : 128 * pn + ci;
    if (pn < 8) return half ? 1536 + 128 * (pn - 4) + ci : 512 + 128 * (pn - 4) + ci;
    if (pn < 14) return 2048 + 256 * (pn - 8) + c;
    if (pn == 14) return half ? 3712 + ci : 3584 + ci;
    if (pn == 15) return 3840 + c;
    return half ? -1 : 4096 + ci; }
  if (id == 2) return n < 384 ? n : (n < 448 ? 640 + (n - 384) : (n < 512 ? -1 : (n < 768 ? 384 + (n - 512) : n - 64)));
  return n; }
__device__ __forceinline__ void transpose_tile(const float* __restrict__ W, int K, int N, bf16_t* __restrict__ Wt, int id, int tile, bf16_t* T, int tid, const float* __restrict__ kgain = nullptr) {
  const int nkt = K >> 6, n0 = (tile / nkt) << 6, k0 = (tile % nkt) << 6, src0 = wsrc_col(id, n0);
  const int kr = tid >> 4, c4 = (tid & 15) * 4;
#pragma unroll
  for (int pz = 0; pz < 2; ++pz) { const int k = k0 + pz * 32 + kr; f32x4 v = {0.f, 0.f, 0.f, 0.f};
    if (src0 >= 0) v = *(const f32x4*)(W + (size_t)k * N + src0 + c4);
    if (kgain) v = v * kgain[k];
    const unsigned lo = cvtpk(v[0], v[1]), hi = cvtpk(v[2], v[3]);
    T[(c4 + 0) * 72 + pz * 32 + kr] = (bf16_t)(lo & 0xffffu); T[(c4 + 1) * 72 + pz * 32 + kr] = (bf16_t)(lo >> 16);
    T[(c4 + 2) * 72 + pz * 32 + kr] = (bf16_t)(hi & 0xffffu); T[(c4 + 3) * 72 + pz * 32 + kr] = (bf16_t)(hi >> 16); }
  __syncthreads();
  { const int n = tid >> 3, k8 = (tid & 7) * 8; *(u32x4*)(Wt + (size_t)(n0 + n) * K + k0 + k8) = *(const u32x4*)(T + n * 72 + k8); }
  __syncthreads();
}
__device__ __forceinline__ void p0_prologue(const Params& p, unsigned char* ldsg) {
  const int tid = opaque_tid(), wid = tid >> 6, lane = tid & 63;
  float* sc = (float*)ldsg; float* red = sc + 9 * 1024;
  float* mod = (float*)(p.ws + OFF_MOD);
  for (int it = blockIdx.x; it < 96; it += gridDim.x) {
    for (int i = tid; i < 9 * 1024; i += 512) { const int bb = i >> 10, k = i & 1023; const float c = bb < 8 ? p.in[1][bb * 1024 + k] : p.in[3][k]; sc[i] = siluf_(c); }
    __syncthreads();
    const int l = it / 48, n0 = (it % 48) * 64; const float* W = p.in[4] + (size_t)l * 1024 * 3072 + n0 + lane; const int k0 = wid * 128;
    float acc[9];
#pragma unroll
    for (int bb = 0; bb < 9; ++bb) acc[bb] = 0.f;
#pragma unroll 16
    for (int k = 0; k < 128; ++k) { const float w = W[(size_t)(k0 + k) * 3072];
#pragma unroll
      for (int bb = 0; bb < 9; ++bb) acc[bb] += sc[bb * 1024 + k0 + k] * w; }
#pragma unroll
    for (int bb = 0; bb < 9; ++bb) red[(wid * 9 + bb) * 64 + lane] = acc[bb];
    __syncthreads();
    for (int i = tid; i < 9 * 64; i += 512) { const int bb = i >> 6, ln = i & 63; float s = 0.f;
#pragma unroll
      for (int w = 0; w < 8; ++w) s += red[(w * 9 + bb) * 64 + ln];
      mod[(l * 9 + bb) * 3072 + n0 + ln] = s + p.in[5][l * 3072 + n0 + ln]; }
    __syncthreads();
  }
  const int gtid = blockIdx.x * 512 + tid, gn = gridDim.x * 512;
  { bf16_t* T = (bf16_t*)(ldsg + 65536);
    auto do_tile = [&](int t) {
      if (t < 1088) transpose_tile(p.in[7], 1024, 4224, (bf16_t*)(p.ws + OFF_W0T), 0, t, T, tid);
      else if (t < 1344) transpose_tile(p.in[19], 1024, 1024, (bf16_t*)(p.ws + OFF_WOUT0T), 1, t - 1088, T, tid);
      else if (t < 1792) transpose_tile(p.in[20], 1024, 1728, (bf16_t*)(p.ws + OFF_W1T), 2, t - 1344, T, tid);
      else if (t < 1936) transpose_tile(p.in[23], 384, 1536, (bf16_t*)(p.ws + OFF_WQBT), 3, t - 1792, T, tid, p.in[21]);
      else if (t < 2064) transpose_tile(p.in[24], 256, 2048, (bf16_t*)(p.ws + OFF_WKVBT), 4, t - 1936, T, tid);
      else transpose_tile(p.in[29], 1024, 1024, (bf16_t*)(p.ws + OFF_WOT), 5, t - 2064, T, tid); };
    const int w = blockIdx.x, G = gridDim.x;
    if (G >= 256) { if (w < 96) { for (int t = w; t < 2320; t += 576) do_tile(t); }
                    else if (w < 256) { for (int j = 0; j < 3; ++j) for (int t = 96 + (w - 96) + j * 160; t < 2320; t += 576) do_tile(t); } }
    else for (int t = w; t < 2320; t += G) do_tile(t); }
  { float* tab = (float*)(p.ws + OFF_ROPE);
    for (int i = gtid; i < 1024; i += gn) { const int idx = i >> 4, pr = i & 15; const float inv = exp2f(-(float)pr * (13.287712379549449f / 16.f)); float sn, cs; sincosf((float)idx * inv, &sn, &cs);
      tab[i * 2] = cs; tab[i * 2 + 1] = sn; } }
}

__device__ __forceinline__ const float* xin_row(const Params& p, int g) { const int b = g / TPB, pos = g - b * TPB;
  return pos < CL ? p.in[2] + (size_t)(b * CL + pos) * DM : p.in[0] + (size_t)(b * SEQ + pos - CL) * DM; }
__device__ __forceinline__ void modnorm_phase(const Params& p, int l) {
  const int tid_ = opaque_tid(), wid = tid_ >> 6, lane = tid_ & 63, gw = blockIdx.x * 8 + wid, nw = gridDim.x * 8;
  const float* mod = (const float*)(p.ws + OFF_MOD); const float* nwp = p.in[6] + l * 1024;
  bf16_t* H = (bf16_t*)(p.ws + (l ? OFF_H1 : OFF_H)); const bf16_t* D0 = (const bf16_t*)(p.ws + OFF_DELTA0);
  for (int g0 = gw; g0 < MR; g0 += 2 * nw) { const int g1 = g0 + nw; const bool two = g1 < MR; const int gB = two ? g1 : g0;
    const float* srcA = xin_row(p, g0); const float* srcB = xin_row(p, gB);
    f32x4 vA[4], vB[4]; u32x2 dA[4], dB[4];
#pragma unroll
    for (int i = 0; i < 4; ++i) { vA[i] = *(const f32x4*)(srcA + i * 256 + lane * 4); vB[i] = *(const f32x4*)(srcB + i * 256 + lane * 4);
      if (l) { dA[i] = *(const u32x2*)(D0 + (size_t)g0 * 1024 + i * 256 + lane * 4); dB[i] = *(const u32x2*)(D0 + (size_t)gB * 1024 + i * 256 + lane * 4); } }
#define MN_ROW(g, v, d) do { const int b_ = (g) / TPB, pos_ = (g) - b_ * TPB, bb_ = pos_ < CL ? 8 : b_; float ss_ = 0.f; \
      _Pragma("unroll") for (int i = 0; i < 4; ++i) { \
        if (l) { v[i][0] += __uint_as_float(d[i].x << 16); v[i][1] += __uint_as_float(d[i].x & 0xffff0000u); v[i][2] += __uint_as_float(d[i].y << 16); v[i][3] += __uint_as_float(d[i].y & 0xffff0000u); } \
        ss_ += v[i][0] * v[i][0] + v[i][1] * v[i][1] + v[i][2] * v[i][2] + v[i][3] * v[i][3]; } \
      ss_ = wave_sum(ss_); const float rstd_ = rsqrtf(ss_ * (1.f / 1024.f) + 1e-6f); const float* md_ = mod + (l * 9 + bb_) * 3072; \
      if (l && lane == 0) ((float*)(p.ws + OFF_SSQ))[(g)] = 0.f; \
      _Pragma("unroll") for (int i = 0; i < 4; ++i) { const int col_ = i * 256 + lane * 4; const f32x4 w_ = *(const f32x4*)(nwp + col_), sh_ = *(const f32x4*)(md_ + col_), sl_ = *(const f32x4*)(md_ + 1024 + col_); \
        const f32x4 h_ = v[i] * rstd_ * w_ * (sl_ + 1.f) + sh_; *(u32x2*)(H + (size_t)(g) * 1024 + col_) = (u32x2){cvtpk(h_[0], h_[1]), cvtpk(h_[2], h_[3])}; } } while (0)
    MN_ROW(g0, vA, dA);
    if (two) MN_ROW(g1, vB, dB);
#undef MN_ROW
  }
}

struct F0 { bf16_t* CUG; bf16_t* RW; bf16_t* ZB;
  __device__ __forceinline__ void operator()(int row, int pn, int c, f32x4 a0, f32x4 a1, f32x4 b0, f32x4 b1) const {
    if (pn < 4) st8(CUG + (size_t)row * 1024 + 128 * pn + c, a0 * b0, a1 * b1);
    else if (pn < 8) st8(CUG + (size_t)row * 1024 + 512 + 128 * (pn - 4) + c, a0 * silu4(b0), a1 * silu4(b1));
    else if (pn < 14) { bf16_t* d = RW + (size_t)row * 1664 + 256 * (pn - 8) + c; st8(d, a0, a1); st8(d + 128, b0, b1); }
    else if (pn == 14) { st8(RW + (size_t)row * 1664 + 1536 + c, a0, a1); st8(ZB + (size_t)row * 512 + c, silu4(b0), silu4(b1)); }
    else if (pn == 15) { st8(ZB + (size_t)row * 512 + 128 + c, silu4(a0), silu4(a1)); st8(ZB + (size_t)row * 512 + 256 + c, silu4(b0), silu4(b1)); }
    else st8(ZB + (size_t)row * 512 + 384 + c, silu4(a0), silu4(a1)); } };

__device__ __forceinline__ void rwkv_prep_phase(const Params& p) {
  const int tid_ = opaque_tid(), wid = tid_ >> 6, lane = tid_ & 63, gw = blockIdx.x * 8 + wid, nw = gridDim.x * 8, sub = lane & 15;
  const bf16_t* RW = (const bf16_t*)(p.ws + OFF_RW); bf16_t* LA = (bf16_t*)(p.ws + OFF_LA);
  float m[8]; ld8f(p.in[9] + 1536 + sub * 8, m);
  for (int g = gw * 4 + (lane >> 4); g < MR; g += nw * 4) { const int pos = g % TPB; const bool hp = (pos != 0 && pos != CL), hn = (pos != CL - 1 && pos != TPB - 1);
    const bf16_t* cur = RW + (size_t)g * 1664 + 1536 + sub * 8; float c[8], pv[8], nx[8], o[8], z[8];
    ld8bf(cur, c); ld8bf(hp ? cur - 1664 : cur, pv); ld8bf(hn ? cur + 1664 : cur, nx);
#pragma unroll
    for (int i = 0; i < 8; ++i) { const float pvv = hp ? pv[i] : 0.f, nxv = hn ? nx[i] : 0.f; o[i] = c[i] + m[i] * (0.5f * (pvv + nxv) - c[i]); if (sub < 8) o[i] = tanhf(o[i]); z[i] = 0.f; }
    st8bf(LA + (size_t)g * 256 + sub * 8, o); st8bf(LA + (size_t)g * 256 + 128 + sub * 8, z); }
}

struct FL { _Float16* E0; _Float16* E1; _Float16* I0; _Float16* I1; const float* w0; const float* a0;
  __device__ __forceinline__ void operator()(int row, int pn, int c, f32x4 x0, f32x4 x1, f32x4 y0, f32x4 y1) const {
    const int dir = pn >> 2, kind = (pn >> 1) & 1, cb = 256 * (pn & 1) + c; const float* bias = (kind ? a0 : w0) + dir * 512; const float scl = kind ? 1.f : 0.6065306597126334f;
    _Float16* dst = E0 + (size_t)kind * (size_t)(I0 - E0) + (size_t)dir * ((size_t)MR * 512) + (size_t)row * 512 + cb; float bs[8]; h16x8 o;
    ld8f(bias + cb, bs);
#pragma unroll
    for (int i = 0; i < 4; ++i) { o[i] = (_Float16)(scl * sigmoidf_(bs[i] + x0[i])); o[4 + i] = (_Float16)(scl * sigmoidf_(bs[4 + i] + x1[i])); }
    *(h16x8*)dst = o;
    ld8f(bias + cb + 128, bs);
#pragma unroll
    for (int i = 0; i < 4; ++i) { o[i] = (_Float16)(scl * sigmoidf_(bs[i] + y0[i])); o[4 + i] = (_Float16)(scl * sigmoidf_(bs[4 + i] + y1[i])); }
    *(h16x8*)(dst + 128) = o; asm volatile("" ::: "memory"); } };

constexpr int SC_CH = 32  , SC_STEP = 352  , SC_BUF = SC_CH * SC_STEP * 4  , SC_NCH = TPB / SC_CH  ;
__device__ __forceinline__ int scan_pos(int d, int sg) { return d == 0 ? sg : (sg < CL ? CL - 1 - sg : TPB + CL - 1 - sg); }
__device__ __forceinline__ void scan_phase(const Params& p, unsigned char* ldsg) {
  const int tid = opaque_tid(), wid = tid >> 6, lane = tid & 63;
  _Float16* ypart = (_Float16*)(ldsg + 2 * SC_BUF);
  float* eic = (float*)(ldsg + 2 * SC_BUF + 32768);
  const bf16_t* RW = (const bf16_t*)(p.ws + OFF_RW);
  for (int item = blockIdx.x; item < 256; item += gridDim.x) {
    const int chain = item >> 1, rh = item & 1, b = chain >> 4, h = (chain >> 1) & 7, d = chain & 1;
    const _Float16* E = (const _Float16*)(p.ws + OFF_E16 + (size_t)d * SZ_M512_2); const _Float16* IC = (const _Float16*)(p.ws + OFF_IC16 + (size_t)d * SZ_M512_2);
    _Float16* Y = (_Float16*)(p.ws + OFF_Y16 + (size_t)d * SZ_M512_2);
    const int tl = tid - 256, ls = tl >> 3, j8 = (tl & 7) * 8; float ka[8];
    float rkv[8], kkw[8]; float* TS = (float*)(p.ws + OFF_TS) + (size_t)d * MR * 8;

    u32x4 g_c[3], g_p[3], g_n[3]; bool g_hp = false, g_hn = false;
    const int lkind = (wid >> 1) & 1, lnb = wid & 1, lr32 = lane & 31, lhi = lane >> 5; bf16x8 lB[4], lA[4]; float lbias = 0.f;
    const bf16_t* LAp = (const bf16_t*)(p.ws + OFF_LA);
    if (wid >= 4) { const float* W = (lkind ? p.in[15] : p.in[13]) + (size_t)d * 64 * 512 + h * 64 + lnb * 32 + lr32;
#pragma unroll
      for (int kk = 0; kk < 4; ++kk) { float f[8];
#pragma unroll
        for (int e2 = 0; e2 < 8; ++e2) f[e2] = W[(size_t)(kk * 16 + lhi * 8 + e2) * 512];
        const u32x4 pk = pack8(f); lB[kk] = *reinterpret_cast<const bf16x8*>(&pk); }
      lbias = (lkind ? p.in[14] : p.in[12])[d * 512 + h * 64 + lnb * 32 + lr32]; }
    auto lora_issue = [&](int c) { const int pos = scan_pos(d, c * SC_CH + lr32); const bf16_t* src = LAp + (size_t)(b * TPB + pos) * 256 + lkind * 64 + lhi * 8;
#pragma unroll
      for (int kk = 0; kk < 4; ++kk) lA[kk] = *(const bf16x8*)(src + kk * 16); };
    auto lora_compute = [&](int c) { f32x16 acc = {};
#pragma unroll
      for (int kk = 0; kk < 4; ++kk) acc = __builtin_amdgcn_mfma_f32_32x32x16_bf16(lA[kk], lB[kk], acc, 0, 0, 0);
      float* dst = eic + (c & 1) * 4096 + lkind * 2048 + lnb * 32 + lr32; const float scl = lkind ? 1.f : 0.6065306597126334f;
#pragma unroll
      for (int r = 0; r < 16; ++r) { const int step = (r & 3) + 8 * (r >> 2) + 4 * lhi; dst[step * 64] = scl * sigmoidf_(acc[r] + lbias); } };
    auto issue_loads = [&](int c) { const int pos = scan_pos(d, c * SC_CH + ls); const size_t g = (size_t)(b * TPB + pos); const size_t off = g * 512 + h * 64 + j8;
      g_hp = (pos != 0 && pos != CL); g_hn = (pos != CL - 1 && pos != TPB - 1);
      const bf16_t* cur = RW + g * 1664 + h * 64 + j8;
#pragma unroll
      for (int q = 0; q < 3; ++q) { g_c[q] = *(const u32x4*)(cur + q * 512); g_p[q] = *(const u32x4*)((g_hp ? cur - 1664 : cur) + q * 512); g_n[q] = *(const u32x4*)((g_hn ? cur + 1664 : cur) + q * 512); }
      (void)off; };
    auto write_chunk = [&](int c) {
      float r[8], k[8], v[8], a[8], e[8], ic[8], w[8], bv[8], kd[8], mu_[3][8];
#pragma unroll
      for (int q = 0; q < 3; ++q) ld8f(p.in[9] + q * 512 + h * 64 + j8, mu_[q]);
      ld8f(p.in[11] + h * 64 + j8, ka); ld8f(p.in[16] + h * 64 + j8, rkv); ld8f(p.in[10] + h * 64 + j8, kkw);
#pragma unroll
      for (int q = 0; q < 3; ++q) { float cc[8], pp[8], nn[8]; unpack8(g_c[q], cc); unpack8(g_p[q], pp); unpack8(g_n[q], nn);
#pragma unroll
        for (int i = 0; i < 8; ++i) { const float pvv = g_hp ? pp[i] : 0.f, nxv = g_hn ? nn[i] : 0.f; const float o = cc[i] + mu_[q][i] * (0.5f * (pvv + nxv) - cc[i]);
          if (q == 0) r[i] = o; else if (q == 1) k[i] = o; else v[i] = o; } }
      { float ss = 0.f;
#pragma unroll
        for (int i = 0; i < 8; ++i) { a[i] = k[i] * kkw[i]; ss += a[i] * a[i]; }
        ss = red8(ss); const float inv = -1.f / fmaxf(sqrtf(ss), 1e-12f);
#pragma unroll
        for (int i = 0; i < 8; ++i) a[i] *= inv; }
      ld8f(eic + (c & 1) * 4096 + ls * 64 + j8, e); ld8f(eic + (c & 1) * 4096 + 2048 + ls * 64 + j8, ic);
#pragma unroll
      for (int i = 0; i < 8; ++i) { w[i] = __builtin_amdgcn_exp2f(-1.4426950408889634f * e[i]); bv[i] = -a[i] * ic[i]; kd[i] = k[i] * (1.f + (ic[i] - 1.f) * ka[i]); }
      { float t = 0.f;
#pragma unroll
        for (int i = 0; i < 8; ++i) t += r[i] * kd[i] * rkv[i];
        t = red8(t);
        if (rh == 0 && (tl & 7) == 0) TS[(size_t)(b * TPB + scan_pos(d, c * SC_CH + ls)) * 8 + h] = t; }
      float* o = (float*)(ldsg + (c & 1) * SC_BUF) + ls * SC_STEP + j8;
      *(f32x4*)(o) = (f32x4){a[0], a[1], a[2], a[3]}; *(f32x4*)(o + 4) = (f32x4){a[4], a[5], a[6], a[7]};
      *(f32x4*)(o + 64) = (f32x4){w[0], w[1], w[2], w[3]}; *(f32x4*)(o + 68) = (f32x4){w[4], w[5], w[6], w[7]};
      *(f32x4*)(o + 128) = (f32x4){bv[0], bv[1], bv[2], bv[3]}; *(f32x4*)(o + 132) = (f32x4){bv[4], bv[5], bv[6], bv[7]};
      *(f32x4*)(o + 192) = (f32x4){kd[0], kd[1], kd[2], kd[3]}; *(f32x4*)(o + 196) = (f32x4){kd[4], kd[5], kd[6], kd[7]};
      *(f32x4*)(o + 256) = (f32x4){r[0], r[1], r[2], r[3]}; *(f32x4*)(o + 260) = (f32x4){r[4], r[5], r[6], r[7]};
      if ((j8 >> 5) == rh) { float* ov = (float*)(ldsg + (c & 1) * SC_BUF) + ls * SC_STEP + 320 + (j8 & 31);
        *(f32x4*)(ov) = (f32x4){v[0], v[1], v[2], v[3]}; *(f32x4*)(ov + 4) = (f32x4){v[4], v[5], v[6], v[7]}; } };
    auto flush_y = [&](int c) { const int pos = scan_pos(d, c * SC_CH + ls), r4 = (tl & 7) * 4; const _Float16* yp = ypart + (c & 1) * 8192 + (ls * 32 + r4) * 8; h16x4 o;
#pragma unroll
      for (int q = 0; q < 4; ++q) { const h16x8 u = *(const h16x8*)(yp + q * 8); o[q] = (_Float16)((((float)u[0] + (float)u[1]) + ((float)u[2] + (float)u[3])) + (((float)u[4] + (float)u[5]) + ((float)u[6] + (float)u[7]))); }
      *(h16x4*)(Y + (size_t)(b * TPB + pos) * 512 + h * 64 + rh * 32 + r4) = o; };
    const int rl = lane >> 3, jg = lane & 7; f32x2 S0 = {0.f, 0.f}, S1 = {0.f, 0.f}, S2 = {0.f, 0.f}, S3 = {0.f, 0.f};
    if (wid >= 4) { lora_issue(0); issue_loads(0); lora_compute(0); lora_issue(1); lora_compute(1); }
    __syncthreads();
    if (wid >= 4) write_chunk(0);
    __syncthreads();
    if (wid < 4) __builtin_amdgcn_s_setprio(3);
    for (int c = 0; c < SC_NCH; ++c) {
      if (wid >= 4) { if (c + 1 < SC_NCH) issue_loads(c + 1); if (c + 2 < SC_NCH) lora_issue(c + 2); if (c >= 1) flush_y(c - 1); if (c + 2 < SC_NCH) lora_compute(c + 2); if (c + 1 < SC_NCH) write_chunk(c + 1); }
      else { const float* ob = (const float*)(ldsg + (c & 1) * SC_BUF) + jg * 8; const float* vb = (const float*)(ldsg + (c & 1) * SC_BUF) + 320 + wid * 8 + rl;
        _Float16* yb = ypart + (c & 1) * 8192 + (wid * 8 + rl) * 8 + jg;
#define SC_LD(X, s) do { const float* o_ = ob + (s) * SC_STEP; X##a0 = *(const f32x4*)(o_); X##a1 = *(const f32x4*)(o_ + 4); X##w0 = *(const f32x4*)(o_ + 64); X##w1 = *(const f32x4*)(o_ + 68); \
          X##b0 = *(const f32x4*)(o_ + 128); X##b1 = *(const f32x4*)(o_ + 132); X##k0 = *(const f32x4*)(o_ + 192); X##k1 = *(const f32x4*)(o_ + 196); \
          X##r0 = *(const f32x4*)(o_ + 256); X##r1 = *(const f32x4*)(o_ + 260); X##v = vb[(s) * SC_STEP]; } while (0)
#define LO2(x) __builtin_shufflevector(x, x, 0, 1)
#define HI2(x) __builtin_shufflevector(x, x, 2, 3)
#define SC_STEPF(X, sidx) do {   \
          f32x2 dA_ = S0 * LO2(X##a0), dB_ = S2 * LO2(X##a1); dA_ = S1 * HI2(X##a0) + dA_; dB_ = S3 * HI2(X##a1) + dB_; const f32x2 d_ = dA_ + dB_; \
          const f32x2 v2_ = {X##v, X##v}; \
          const f32x2 q0_ = S0 * LO2(X##w0) + v2_ * LO2(X##k0), q1_ = S1 * HI2(X##w0) + v2_ * HI2(X##k0), q2_ = S2 * LO2(X##w1) + v2_ * LO2(X##k1), q3_ = S3 * HI2(X##w1) + v2_ * HI2(X##k1); \
          const float sa_ = red8(d_.x + d_.y); const f32x2 sa2_ = {sa_, sa_}; \
          S0 = sa2_ * LO2(X##b0) + q0_; S1 = sa2_ * HI2(X##b0) + q1_; S2 = sa2_ * LO2(X##b1) + q2_; S3 = sa2_ * HI2(X##b1) + q3_; \
          f32x2 yA_ = S0 * LO2(X##r0), yB_ = S2 * LO2(X##r1); yA_ = S1 * HI2(X##r0) + yA_; yB_ = S3 * HI2(X##r1) + yB_; const f32x2 y_ = yA_ + yB_; \
          yb[(sidx) * 256] = (_Float16)(y_.x + y_.y); } while (0)
        f32x4 Aa0, Aa1, Aw0, Aw1, Ab0, Ab1, Ak0, Ak1, Ar0, Ar1, Ba0, Ba1, Bw0, Bw1, Bb0, Bb1, Bk0, Bk1, Br0, Br1; float Av, Bv;
        SC_LD(A, 0);
        for (int s8 = 0; s8 < SC_CH; s8 += 8) {
#pragma unroll
          for (int u = 0; u < 8; u += 2) { const int s = s8 + u;
            SC_LD(B, s + 1); SC_STEPF(A, s);
            SC_LD(A, (s + 2 < SC_CH ? s + 2 : SC_CH - 1)); SC_STEPF(B, s + 1); } }
#undef SC_LD
#undef SC_STEPF
      }
      __syncthreads();
    }
    __builtin_amdgcn_s_setprio(0);
    if (wid >= 4) flush_y(SC_NCH - 1);
    __syncthreads();
  }
}

__device__ __forceinline__ void even_out_phase(const Params& p) {
  const int tid_ = opaque_tid(), wid = tid_ >> 6, lane = tid_ & 63, gw = blockIdx.x * 8 + wid, nw = gridDim.x * 8, ch = lane * 8;
  const bf16_t* CUG = (const bf16_t*)(p.ws + OFF_CUG); const bf16_t* ZB = (const bf16_t*)(p.ws + OFF_ZB); bf16_t* MIX = (bf16_t*)(p.ws + OFF_MIX);
  const bf16_t* RW = (const bf16_t*)(p.ws + OFF_RW); const float* TS0 = (const float*)(p.ws + OFF_TS); const float* TS1 = TS0 + (size_t)MR * 8;
  const _Float16* Y0 = (const _Float16*)(p.ws + OFF_Y16); const _Float16* Y1 = Y0 + (size_t)MR * 512;
  float cw0[8], cw1[8], cw2[8], lw[8], lb[8], muv[8];
  ld8f(p.in[9] + 1024 + ch, muv); ld8f(p.in[8] + ch, cw0); ld8f(p.in[8] + 512 + ch, cw1); ld8f(p.in[8] + 1024 + ch, cw2); ld8f(p.in[17] + ch, lw); ld8f(p.in[18] + ch, lb);
  for (int g = gw; g < MR; g += nw) { const int pos = g % TPB; const bool hp = (pos != 0 && pos != CL), hn = (pos != CL - 1 && pos != TPB - 1);
    const bf16_t* cu = CUG + (size_t)g * 1024 + ch; float c[8], pv[8], nx[8], gg[8], o[8];
    ld8bf(cu, c); ld8bf(cu + 512, gg);
    if (hp) ld8bf(cu - 1024, pv); else {
#pragma unroll
      for (int i = 0; i < 8; ++i) pv[i] = 0.f; }
    if (hn) ld8bf(cu + 1024, nx); else {
#pragma unroll
      for (int i = 0; i < 8; ++i) nx[i] = 0.f; }
#pragma unroll
    for (int i = 0; i < 8; ++i) o[i] = gg[i] * (cw0[i] * pv[i] + cw1[i] * c[i] + cw2[i] * nx[i]);
    st8bf(MIX + (size_t)g * 1024 + ch, o);
    const size_t off = (size_t)g * 512 + ch; float y0[8], y1[8], v[8], zb[8];
    ld8h(Y0 + off, y0); ld8h(Y1 + off, y1); ld8bf(ZB + off, zb);
    { const bf16_t* vr = RW + (size_t)g * 1664 + 1024 + ch; float vc[8], vp[8], vn[8]; ld8bf(vr, vc); ld8bf(hp ? vr - 1664 : vr, vp); ld8bf(hn ? vr + 1664 : vr, vn);
#pragma unroll
      for (int i = 0; i < 8; ++i) { const float pvv = hp ? vp[i] : 0.f, nxv = hn ? vn[i] : 0.f; v[i] = vc[i] + muv[i] * (0.5f * (pvv + nxv) - vc[i]); } }
    const float t = TS0[(size_t)g * 8 + (lane >> 3)] + TS1[(size_t)g * 8 + (lane >> 3)];
    float s = 0.f;
#pragma unroll
    for (int i = 0; i < 8; ++i) { y0[i] += y1[i]; s += y0[i]; }
    s = red8(s); const float mean = s * (1.f / 64.f); float q = 0.f;
#pragma unroll
    for (int i = 0; i < 8; ++i) { y0[i] -= mean; q += y0[i] * y0[i]; }
    q = red8(q); const float rstd = rsqrtf(q * (1.f / 64.f) + 64e-5f);
#pragma unroll
    for (int i = 0; i < 8; ++i) o[i] = (y0[i] * rstd * lw[i] + lb[i] + t * v[i]) * zb[i];
    st8bf(MIX + (size_t)g * 1024 + 512 + ch, o); }
}

struct F6 { bf16_t* D0; const float* gate;
  __device__ __forceinline__ void operator()(int row, int pn, int c, f32x4 a0, f32x4 a1, f32x4 b0, f32x4 b1) const {
    const int b = row / TPB, pos = row - b * TPB, bb = pos < CL ? 8 : b; const float* gt = gate + bb * 3072 + 256 * pn + c; bf16_t* d = D0 + (size_t)row * 1024 + 256 * pn + c;
    st8(d, a0 * *(const f32x4*)gt, a1 * *(const f32x4*)(gt + 4)); st8(d + 128, b0 * *(const f32x4*)(gt + 128), b1 * *(const f32x4*)(gt + 132)); } };

struct F8 { bf16_t* P1S; bf16_t* Z;
  __device__ __forceinline__ void operator()(int row, int pn, int c, f32x4 a0, f32x4 a1, f32x4 b0, f32x4 b1) const {
    if (pn < 3) { bf16_t* d = P1S + (size_t)row * 768 + 256 * pn + c; st8(d, a0, a1); st8(d + 128, b0, b1); }
    else { bf16_t* d = Z + (size_t)row * 1024 + 256 * (pn - 3) + c; st8(d, silu4(a0), silu4(a1)); st8(d + 128, silu4(b0), silu4(b1)); } } };
struct FPlain { bf16_t* O; int ld;
  __device__ __forceinline__ void operator()(int row, int pn, int c, f32x4 a0, f32x4 a1, f32x4 b0, f32x4 b1) const { bf16_t* d = O + (size_t)row * ld + 256 * pn + c; st8(d, a0, a1); st8(d + 128, b0, b1); } };

struct EpiP9 { static constexpr bool PERM = true, AFTER_DRAIN = false; unsigned char* ws; const float* gkv; const float* gkr; PG8_LAS float* part;
  __device__ __forceinline__ void operator()(const f32x4 (&acc)[2][2][4][2], const pg8::Unit& u, int wr, int wc, int fr, int fq) const {
    bf16_t* const P1S = (bf16_t*)(ws + OFF_P1S); bf16_t* const Z = (bf16_t*)(ws + OFF_Z); bf16_t* const KVAN = (bf16_t*)(ws + OFF_KVAN); bf16_t* const KR = (bf16_t*)(ws + OFF_KROPE);
    const float* const rtab = (const float*)(ws + OFF_ROPE); float* const ssq = (float*)(ws + OFF_SSQ);
    int c = wc * 32 + 8 * fq; asm volatile("" : "+v"(c));
    const int pn = u.pn;
    if (pn >= 3) {
#pragma unroll
      for (int ai = 0; ai < 2; ++ai)
#pragma unroll
        for (int m = 0; m < 4; ++m) { const size_t row = (size_t)(u.pm * 256 + ai * 128 + wr * 64 + m * 16 + fr);
          { bf16_t* d = Z + row * 1024 + 256 * (pn - 3) + c; st8(d, silu4(acc[ai][0][m][0]), silu4(acc[ai][0][m][1])); st8(d + 128, silu4(acc[ai][1][m][0]), silu4(acc[ai][1][m][1])); } }
      return; }
#define SQ8(a_, b_) ((a_[0] * a_[0] + a_[1] * a_[1]) + (a_[2] * a_[2] + a_[3] * a_[3]) + ((b_[0] * b_[0] + b_[1] * b_[1]) + (b_[2] * b_[2] + b_[3] * b_[3])))
    if (pn <= 1) {
#pragma unroll
      for (int ai = 0; ai < 2; ++ai)
#pragma unroll
        for (int m = 0; m < 4; ++m) { const int rt = ai * 128 + wr * 64 + m * 16 + fr; const size_t row = (size_t)(u.pm * 256 + rt);
          float sq = SQ8(acc[ai][0][m][0], acc[ai][0][m][1]); st8(P1S + row * 384 + 256 * pn + c, acc[ai][0][m][0], acc[ai][0][m][1]);
          if (pn == 0) { sq += SQ8(acc[ai][1][m][0], acc[ai][1][m][1]); st8(P1S + row * 384 + 128 + c, acc[ai][1][m][0], acc[ai][1][m][1]); }
          sq += __shfl_xor(sq, 16); sq += __shfl_xor(sq, 32);
          if (fq == 0) part[1024 + rt * 4 + wc] = sq; asm volatile("" ::: "memory"); } }
    if (pn >= 1)
#pragma unroll
    for (int ai = 0; ai < 2; ++ai)
#pragma unroll
      for (int m = 0; m < 4; ++m) { const f32x4 y0 = acc[ai][1][m][0], y1 = acc[ai][1][m][1];
        float sq = (y0[0] * y0[0] + y0[1] * y0[1]) + (y0[2] * y0[2] + y0[3] * y0[3]) + ((y1[0] * y1[0] + y1[1] * y1[1]) + (y1[2] * y1[2] + y1[3] * y1[3]));
        if (pn == 2) { const f32x4 x0 = acc[ai][0][m][0], x1 = acc[ai][0][m][1];
          sq += (x0[0] * x0[0] + x0[1] * x0[1]) + (x0[2] * x0[2] + x0[3] * x0[3]) + ((x1[0] * x1[0] + x1[1] * x1[1]) + (x1[2] * x1[2] + x1[3] * x1[3])); }
        sq += __shfl_xor(sq, 16); sq += __shfl_xor(sq, 32);
        if (fq == 0) part[(ai * 128 + wr * 64 + m * 16 + fr) * 4 + wc] = sq; }
    asm volatile("s_waitcnt lgkmcnt(0)" ::: "memory"); __builtin_amdgcn_s_barrier(); asm volatile("" ::: "memory");
    if (pn <= 1 && wc == 0 && fq == 0) {
#pragma unroll
      for (int ai = 0; ai < 2; ++ai)
#pragma unroll
        for (int m = 0; m < 4; ++m) { const int rt = ai * 128 + wr * 64 + m * 16 + fr; const f32x4 pr = *(const PG8_LAS f32x4*)(part + 1024 + rt * 4);
          atomicAdd(ssq + (size_t)(u.pm * 256 + rt), (pr[0] + pr[1]) + (pr[2] + pr[3])); } }
    if (pn == 0) return;
    if (pn == 2) { const f32x4 g00 = *(const f32x4*)(gkv + c), g01 = *(const f32x4*)(gkv + c + 4), g10 = *(const f32x4*)(gkv + 128 + c), g11 = *(const f32x4*)(gkv + 128 + c + 4);
#pragma unroll
      for (int ai = 0; ai < 2; ++ai)
#pragma unroll
        for (int m = 0; m < 4; ++m) { const int rt = ai * 128 + wr * 64 + m * 16 + fr; const f32x4 pr = *(const PG8_LAS f32x4*)(part + rt * 4);
          const float rs = rsqrtf(((pr[0] + pr[1]) + (pr[2] + pr[3])) * (1.f / 256.f) + 1e-6f); bf16_t* d = KVAN + (size_t)(u.pm * 256 + rt) * 256 + c;
          st8(d, acc[ai][0][m][0] * rs * g00, acc[ai][0][m][1] * rs * g01); st8(d + 128, acc[ai][1][m][0] * rs * g10, acc[ai][1][m][1] * rs * g11); asm volatile("" ::: "memory"); } }
    else { const bool lat = (u.pm % 17) != 0;
      const f32x4 g0 = *(const f32x4*)(gkr + (c & 63)), g1 = *(const f32x4*)(gkr + (c & 63) + 4); const int half = fq >> 1, pb = 8 * (fq & 1);
#pragma unroll
      for (int ai = 0; ai < 2; ++ai)
#pragma unroll
        for (int m = 0; m < 4; ++m) { const int rt = ai * 128 + wr * 64 + m * 16 + fr; const size_t g = (size_t)(u.pm * 256 + rt);
          const f32x4 pr = *(const PG8_LAS f32x4*)(part + rt * 4); const float rs = rsqrtf(((pr[0] + pr[1]) + (pr[2] + pr[3])) * (1.f / 64.f) + 1e-6f);
          f32x4 x0 = acc[ai][1][m][0] * rs * g0, x1 = acc[ai][1][m][1] * rs * g1;
          if (lat) { const int t = (int)(g % TPB) - CL, idx = (wc & 1) ? (t & 63) : (t >> 6); const float* cs = rtab + (idx * 16 + pb) * 2;
            const float sg = half ? 1.f : -1.f;
            { const f32x4 c0 = *(const f32x4*)(cs), c1 = *(const f32x4*)(cs + 4); const f32x4 o0 = {__shfl_xor(x0[0], 32), __shfl_xor(x0[1], 32), __shfl_xor(x0[2], 32), __shfl_xor(x0[3], 32)};
              x0 = (f32x4){x0[0] * c0[0] + sg * o0[0] * c0[1], x0[1] * c0[2] + sg * o0[1] * c0[3], x0[2] * c1[0] + sg * o0[2] * c1[1], x0[3] * c1[2] + sg * o0[3] * c1[3]}; }
            { const f32x4 c2 = *(const f32x4*)(cs + 8), c3 = *(const f32x4*)(cs + 12); const f32x4 o1 = {__shfl_xor(x1[0], 32), __shfl_xor(x1[1], 32), __shfl_xor(x1[2], 32), __shfl_xor(x1[3], 32)};
              x1 = (f32x4){x1[0] * c2[0] + sg * o1[0] * c2[1], x1[1] * c2[2] + sg * o1[1] * c2[3], x1[2] * c3[0] + sg * o1[2] * c3[1], x1[3] * c3[2] + sg * o1[3] * c3[3]}; } }
          if (wc < 2) st8(KR + g * 64 + c, x0, x1); asm volatile("" ::: "memory"); } }
    asm volatile("" ::: "memory"); } };
struct EpiKV { static constexpr bool PERM = true, AFTER_DRAIN = false; bf16_t* O; const float* gk; PG8_LAS float* part;
  __device__ __forceinline__ void operator()(const f32x4 (&acc)[2][2][4][2], const pg8::Unit& u, int wr, int wc, int fr, int fq) const {
#pragma unroll
    for (int ai = 0; ai < 2; ++ai)
#pragma unroll
      for (int m = 0; m < 4; ++m) { const f32x4 x0 = acc[ai][0][m][0], x1 = acc[ai][0][m][1];
        float sq = (x0[0] * x0[0] + x0[1] * x0[1]) + (x0[2] * x0[2] + x0[3] * x0[3]) + ((x1[0] * x1[0] + x1[1] * x1[1]) + (x1[2] * x1[2] + x1[3] * x1[3]));
        sq += __shfl_xor(sq, 16); sq += __shfl_xor(sq, 32);
        if (fq == 0) part[(ai * 128 + wr * 64 + m * 16 + fr) * 4 + wc] = sq; }
    asm volatile("s_waitcnt lgkmcnt(0)" ::: "memory"); __builtin_amdgcn_s_barrier(); asm volatile("" ::: "memory");
    const int c = wc * 32 + 8 * fq; const f32x4 g0 = *(const f32x4*)(gk + c), g1 = *(const f32x4*)(gk + c + 4);
#pragma unroll
    for (int ai = 0; ai < 2; ++ai)
#pragma unroll
      for (int m = 0; m < 4; ++m) { const int rt = ai * 128 + wr * 64 + m * 16 + fr; const f32x4 pr = *(const PG8_LAS f32x4*)(part + rt * 4);
        const float rs = rsqrtf(((pr[0] + pr[1]) + (pr[2] + pr[3])) * (1.f / 128.f) + 1e-6f);
        bf16_t* d = O + (size_t)(u.pm * 256 + rt) * 2048 + 256 * u.pn + c;
        st8(d, acc[ai][0][m][0] * rs * g0, acc[ai][0][m][1] * rs * g1); st8(d + 128, acc[ai][1][m][0], acc[ai][1][m][1]); }
    asm volatile("" ::: "memory"); } };
__device__ __forceinline__ void rope8(float (&x)[8], int sub, int t, const float* tab) {
  const int axis = sub >> 2, half = (sub >> 1) & 1, p0 = (sub & 1) * 8; const int idx = axis ? (t & 63) : (t >> 6); float cs[16];
  ld8f(tab + (idx * 16 + p0) * 2, *(float(*)[8])&cs[0]); ld8f(tab + (idx * 16 + p0) * 2 + 8, *(float(*)[8])&cs[8]);
#pragma unroll
  for (int i = 0; i < 8; ++i) { const float other = __shfl_xor(x[i], 2); x[i] = half ? (x[i] * cs[2 * i] + other * cs[2 * i + 1]) : (x[i] * cs[2 * i] - other * cs[2 * i + 1]); }
}
__device__ __forceinline__ void lat_norm_phase(const Params& p) {
  const int tid_ = opaque_tid(), wid = tid_ >> 6, lane = tid_ & 63, gw = blockIdx.x * 8 + wid, nw = gridDim.x * 8;
  const bf16_t* P1S = (const bf16_t*)(p.ws + OFF_P1S); bf16_t* QAN = (bf16_t*)(p.ws + OFF_QAN);
  float w[8]; if (lane < 48) ld8f(p.in[21] + lane * 8, w);
  for (int g = gw; g < MR; g += nw) { if (g % TPB < CL) continue; float q[8]; float s1 = 0.f;
#pragma unroll
    for (int i = 0; i < 8; ++i) q[i] = 0.f;
    if (lane < 48) ld8bf(P1S + (size_t)g * 384 + lane * 8, q);
#pragma unroll
    for (int i = 0; i < 8; ++i) s1 += q[i] * q[i];
    s1 = wave_sum(s1); const float r1 = rsqrtf(s1 * (1.f / 384.f) + 1e-6f);
    if (lane < 48) {
#pragma unroll
      for (int i = 0; i < 8; ++i) q[i] *= r1 * w[i];
      st8bf(QAN + (size_t)g * 384 + lane * 8, q); } }
}
__device__ __forceinline__ void head_norm_phase(const Params& p) {
  const int tid_ = opaque_tid(), wid = tid_ >> 6, lane = tid_ & 63, gw = blockIdx.x * 8 + wid, nw = gridDim.x * 8, hd = lane >> 3, sub = lane & 7;
  bf16_t* KV = (bf16_t*)(p.ws + OFF_KVRAW);
  float gkn0[8], gkn1[8];
  ld8f(p.in[27] + sub * 16, gkn0); ld8f(p.in[27] + sub * 16 + 8, gkn1);
  for (int g = gw; g < MR; g += nw) {
    bf16_t* kp = KV + (size_t)g * 2048 + hd * 256 + sub * 16; float a[8], b[8]; ld8bf(kp, a); ld8bf(kp + 8, b); float s = 0.f;
#pragma unroll
    for (int i = 0; i < 8; ++i) s += a[i] * a[i] + b[i] * b[i];
    s = red8(s); const float rs = rsqrtf(s * (1.f / 128.f) + 1e-6f);
#pragma unroll
    for (int i = 0; i < 8; ++i) { a[i] *= rs * gkn0[i]; b[i] *= rs * gkn1[i]; }
    st8bf(kp, a); st8bf(kp + 8, b); }
}
struct F13 { float* out; const float* x; const bf16_t* D0; const float* gate;
  __device__ __forceinline__ void operator()(int row, int pn, int c, f32x4 a0, f32x4 a1, f32x4 b0, f32x4 b1) const {
    const int b = row / TPB, pos = row - b * TPB; if (pos < CL) return;
    const size_t o = (size_t)(b * SEQ + pos - CL) * 1024 + 256 * pn + c; const float* gt = gate + b * 3072 + 256 * pn + c; const bf16_t* d = D0 + (size_t)row * 1024 + 256 * pn + c;
    float d0[8], d1[8]; ld8bf(d, d0); ld8bf(d + 128, d1);
    const f32x4 x0 = *(const f32x4*)(x + o), x1 = *(const f32x4*)(x + o + 4), x2 = *(const f32x4*)(x + o + 128), x3 = *(const f32x4*)(x + o + 132);
    *(f32x4*)(out + o) = x0 + (f32x4){d0[0], d0[1], d0[2], d0[3]} + a0 * *(const f32x4*)gt;
    *(f32x4*)(out + o + 4) = x1 + (f32x4){d0[4], d0[5], d0[6], d0[7]} + a1 * *(const f32x4*)(gt + 4);
    *(f32x4*)(out + o + 128) = x2 + (f32x4){d1[0], d1[1], d1[2], d1[3]} + b0 * *(const f32x4*)(gt + 128);
    *(f32x4*)(out + o + 132) = x3 + (f32x4){d1[4], d1[5], d1[6], d1[7]} + b1 * *(const f32x4*)(gt + 132); } };

namespace att {
constexpr int NW = 8, QBLK = 32, KVBLK = 64, LDQ = 1536, LDK = 2048, LDKR = 64, LDO = 1024;
constexpr int SHM_V = KVBLK * 128 * 2, SHM_K = KVBLK * 128 * 2, SHM_KR = KVBLK * 64 * 2;
constexpr float THR = 8.f;
#define KSWZ(row, colB) ((row) * 256 + ((colB) ^ (((row) & 7) << 4)))
#define KRSWZ(row, colB) ((row) * 128 + ((colB) ^ (((row) & 7) << 4)))
#define SBAR() __builtin_amdgcn_sched_barrier(0)
__device__ __forceinline__ int crow(int r, int hi) { return (r & 3) + 8 * (r >> 2) + 4 * hi; }
__device__ __forceinline__ unsigned cvtpkv(float lo, float hi) { unsigned r; asm("v_cvt_pk_bf16_f32 %0, %1, %2" : "=v"(r) : "v"(lo), "v"(hi)); return r; }
__device__ __forceinline__ void partialSM(f32x16& p0, f32x16& p1, float& m_reg, float& mn, float& alpha) {
  constexpr float C = 1.4426950408889634f;
  float pmax = p0[0];
#pragma unroll
  for (int r = 1; r < 16; ++r) pmax = fmaxf(pmax, p0[r]);
#pragma unroll
  for (int r = 0; r < 16; ++r) pmax = fmaxf(pmax, p1[r]);
  { auto rr = __builtin_amdgcn_permlane32_swap(__float_as_uint(pmax), __float_as_uint(pmax), false, false);
    pmax = fmaxf(__uint_as_float(rr[0]), __uint_as_float(rr[1])); }
  if (__builtin_expect(__all(pmax - m_reg <= THR), 1)) { mn = m_reg; alpha = 1.f; }
  else { mn = fmaxf(m_reg, pmax); alpha = __builtin_amdgcn_exp2f((m_reg - mn) * C); m_reg = mn; }
  const float mnC = -mn * C;
#pragma unroll
  for (int r = 0; r < 16; ++r) p0[r] = fmaf(p0[r], C, mnC);
#pragma unroll
  for (int r = 0; r < 16; ++r) p1[r] = fmaf(p1[r], C, mnC);
#pragma unroll
  for (int r = 0; r < 16; ++r) p0[r] = __builtin_amdgcn_exp2f(p0[r]);
}
__device__ __forceinline__ void finishSM(f32x16& p0, f32x16& p1, float alpha, float& l_reg, bf16x8& pa0, bf16x8& pa1, bf16x8& pa2, bf16x8& pa3) {
#pragma unroll
  for (int r = 0; r < 16; ++r) p1[r] = __builtin_amdgcn_exp2f(p1[r]);
  float ps = 0;
#pragma unroll
  for (int r = 0; r < 16; ++r) ps += p0[r];
#pragma unroll
  for (int r = 0; r < 16; ++r) ps += p1[r];
  { auto rr = __builtin_amdgcn_permlane32_swap(__float_as_uint(ps), __float_as_uint(ps), false, false);
    ps = __uint_as_float(rr[0]) + __uint_as_float(rr[1]); }
  l_reg = l_reg * alpha + ps;
#define PK4(P, BASE, OUT) do { unsigned a0 = cvtpkv(P[BASE + 0], P[BASE + 1]), a1 = cvtpkv(P[BASE + 2], P[BASE + 3]);   \
    unsigned b0 = cvtpkv(P[BASE + 4], P[BASE + 5]), b1 = cvtpkv(P[BASE + 6], P[BASE + 7]);                              \
    auto r0 = __builtin_amdgcn_permlane32_swap(a0, b0, false, false); auto r1 = __builtin_amdgcn_permlane32_swap(a1, b1, false, false); \
    u32x4 w = {r0[0], r1[0], r0[1], r1[1]}; OUT = *reinterpret_cast<bf16x8*>(&w); } while (0)
  PK4(p0, 0, pa0); PK4(p0, 8, pa1); PK4(p1, 0, pa2); PK4(p1, 8, pa3);
#undef PK4
}
__device__ __forceinline__ void qkt(f32x16& p0, f32x16& p1, const char* Ks, const char* KRs, const bf16x8* qr, int r32, int hi) {
  p0 = f32x16{}; p1 = f32x16{};
#pragma unroll
  for (int d0 = 0; d0 < 8; ++d0) { const int cb = (d0 * 16 + hi * 8) * 2;
    const bf16x8 b0 = *reinterpret_cast<const bf16x8*>(Ks + KSWZ(r32, cb));
    const bf16x8 b1 = *reinterpret_cast<const bf16x8*>(Ks + KSWZ(32 + r32, cb));
    p0 = __builtin_amdgcn_mfma_f32_32x32x16_bf16(b0, qr[d0], p0, 0, 0, 0);
    p1 = __builtin_amdgcn_mfma_f32_32x32x16_bf16(b1, qr[d0], p1, 0, 0, 0); }
#pragma unroll
  for (int d0 = 0; d0 < 4; ++d0) { const int cb = (d0 * 16 + hi * 8) * 2;
    const bf16x8 b0 = *reinterpret_cast<const bf16x8*>(KRs + KRSWZ(r32, cb));
    const bf16x8 b1 = *reinterpret_cast<const bf16x8*>(KRs + KRSWZ(32 + r32, cb));
    p0 = __builtin_amdgcn_mfma_f32_32x32x16_bf16(b0, qr[8 + d0], p0, 0, 0, 0);
    p1 = __builtin_amdgcn_mfma_f32_32x32x16_bf16(b1, qr[8 + d0], p1, 0, 0, 0); }
}
__device__ __forceinline__ int v_st(int k, int c) { const int kk = (k & ~0xC) | ((k & 4) << 1) | ((k & 8) >> 1); return ((kk >> 3) * 4 + (c >> 5)) * 512 + ((kk & 7) * 32 + (c & 31)) * 2; }
__device__ __forceinline__ int v_rd_base(int lane) { return ((lane & 3) << 3) | (((lane >> 2) & 3) << 6) | (((lane >> 4) & 1) << 5) | (((lane >> 5) & 1) << 8); }
constexpr int v_rd_off(int d0, int ks, int half) { return d0 * 512 + ks * 4096 + half * 2048; }
template <int OFF> __device__ __forceinline__ s16x4 tr_read(int vb) {
  s16x4 r; asm volatile("ds_read_b64_tr_b16 %0, %1 offset:%2" : "=&v"(r) : "v"(vb), "i"(OFF) : "memory"); return r;
}
#define PKV(L, H) (bf16x8){L[0], L[1], L[2], L[3], H[0], H[1], H[2], H[3]}
struct VFrag { s16x4 l0, h0, l1, h1, l2, h2, l3, h3; };
template <int D0> __device__ __forceinline__ void pv_read(VFrag& f, int vb) {
  f.l0 = tr_read<v_rd_off(D0, 0, 0)>(vb); f.h0 = tr_read<v_rd_off(D0, 0, 1)>(vb); f.l1 = tr_read<v_rd_off(D0, 1, 0)>(vb); f.h1 = tr_read<v_rd_off(D0, 1, 1)>(vb);
  f.l2 = tr_read<v_rd_off(D0, 2, 0)>(vb); f.h2 = tr_read<v_rd_off(D0, 2, 1)>(vb); f.l3 = tr_read<v_rd_off(D0, 3, 0)>(vb); f.h3 = tr_read<v_rd_off(D0, 3, 1)>(vb); }
__device__ __forceinline__ void pv_mma(f32x16& od, const VFrag& f, bf16x8 pa0, bf16x8 pa1, bf16x8 pa2, bf16x8 pa3) {
  od = __builtin_amdgcn_mfma_f32_32x32x16_bf16(pa0, PKV(f.l0, f.h0), od, 0, 0, 0);
  od = __builtin_amdgcn_mfma_f32_32x32x16_bf16(pa1, PKV(f.l1, f.h1), od, 0, 0, 0);
  od = __builtin_amdgcn_mfma_f32_32x32x16_bf16(pa2, PKV(f.l2, f.h2), od, 0, 0, 0);
  od = __builtin_amdgcn_mfma_f32_32x32x16_bf16(pa3, PKV(f.l3, f.h3), od, 0, 0, 0); }
__device__ __forceinline__ void pv_d0(f32x16* o, int vb, bf16x8 pa0, bf16x8 pa1, bf16x8 pa2, bf16x8 pa3) {
  VFrag fa;
  pv_read<0>(fa, vb); asm volatile("s_waitcnt lgkmcnt(0)" ::: "memory"); SBAR(); pv_mma(o[0], fa, pa0, pa1, pa2, pa3); SBAR();
  pv_read<1>(fa, vb); asm volatile("s_waitcnt lgkmcnt(0)" ::: "memory"); SBAR(); pv_mma(o[1], fa, pa0, pa1, pa2, pa3); SBAR();
  pv_read<2>(fa, vb); asm volatile("s_waitcnt lgkmcnt(0)" ::: "memory"); SBAR(); pv_mma(o[2], fa, pa0, pa1, pa2, pa3); SBAR();
  pv_read<3>(fa, vb); asm volatile("s_waitcnt lgkmcnt(0)" ::: "memory"); SBAR(); pv_mma(o[3], fa, pa0, pa1, pa2, pa3);
}
__device__ __forceinline__ void attn_unit(const bf16_t* __restrict__ Qb, const bf16_t* __restrict__ Kh, const bf16_t* __restrict__ KRh, const bf16_t* __restrict__ Vh,
                                          const bf16_t* __restrict__ Zb, bf16_t* __restrict__ Ob, int seq, char* lds,
                                          const float* __restrict__ gqn, const float* __restrict__ gqr, const float* __restrict__ rtab, int t0, const float* __restrict__ ssq) {
  const int tid = opaque_tid(), wid = tid >> 6, lane = tid & 63, r32 = lane & 31, hi = lane >> 5;
  char* V_lds = lds; char* K_lds = lds + 3 * SHM_V; char* KR_lds = lds + 3 * SHM_V + 3 * SHM_K;
  float* ws = (float*)(lds + 3 * SHM_V + 3 * SHM_K + 3 * SHM_KR) + wid * 64; float* li_l = ws; float* al_l = ws + 32;
  float m_reg = -1e30f, l_reg = 0; f32x16 o[4] = {}; bf16x8 qr[12];
  const bf16_t* Qw = Qb + (long)(wid * QBLK + r32) * LDQ + hi * 8;
#pragma unroll
  for (int d0 = 0; d0 < 12; ++d0) qr[d0] = *reinterpret_cast<const bf16x8*>(Qw + d0 * 16);
  {
    float ssn = 0.f, ssr = 0.f;
#pragma unroll
    for (int d0 = 0; d0 < 12; ++d0) { float f[8]; unpack8(*reinterpret_cast<const u32x4*>(&qr[d0]), f); float t_ = 0.f;
#pragma unroll
      for (int e = 0; e < 8; ++e) t_ += f[e] * f[e];
      if (d0 < 8) ssn += t_; else ssr += t_; }
    { auto rr = __builtin_amdgcn_permlane32_swap(__float_as_uint(ssn), __float_as_uint(ssn), false, false); ssn = __uint_as_float(rr[0]) + __uint_as_float(rr[1]); }
    { auto rr = __builtin_amdgcn_permlane32_swap(__float_as_uint(ssr), __float_as_uint(ssr), false, false); ssr = __uint_as_float(rr[0]) + __uint_as_float(rr[1]); }
    const float rq = rsqrtf(ssq[wid * QBLK + r32] * (1.f / 384.f) + 1e-6f);
    const float rsn = rq * rsqrtf(ssn * rq * rq * (1.f / 128.f) + 1e-6f) * SM_SCALE, rsr = rq * rsqrtf(ssr * rq * rq * (1.f / 64.f) + 1e-6f) * SM_SCALE;
#pragma unroll
    for (int d0 = 0; d0 < 8; ++d0) { float f[8], g[8]; unpack8(*reinterpret_cast<const u32x4*>(&qr[d0]), f); ld8f(gqn + d0 * 16 + hi * 8, g);
#pragma unroll
      for (int e = 0; e < 8; ++e) f[e] *= rsn * g[e];
      const u32x4 w = pack8(f); qr[d0] = *reinterpret_cast<const bf16x8*>(&w); }
    const int tq = t0 + wid * QBLK + r32;
#pragma unroll
    for (int ax = 0; ax < 2; ++ax) { float f1[8], f2[8], g1[8], g2[8], cs[16]; unpack8(*reinterpret_cast<const u32x4*>(&qr[8 + 2 * ax]), f1); unpack8(*reinterpret_cast<const u32x4*>(&qr[9 + 2 * ax]), f2);
      ld8f(gqr + ax * 32 + hi * 8, g1); ld8f(gqr + ax * 32 + 16 + hi * 8, g2);
      const int idx = ax ? (tq & 63) : (tq >> 6); ld8f(rtab + (idx * 16 + hi * 8) * 2, *(float(*)[8])&cs[0]); ld8f(rtab + (idx * 16 + hi * 8) * 2 + 8, *(float(*)[8])&cs[8]);
#pragma unroll
      for (int e = 0; e < 8; ++e) { const float a = f1[e] * rsr * g1[e], b = f2[e] * rsr * g2[e]; f1[e] = a * cs[2 * e] - b * cs[2 * e + 1]; f2[e] = b * cs[2 * e] + a * cs[2 * e + 1]; }
      const u32x4 w1 = pack8(f1), w2 = pack8(f2); qr[8 + 2 * ax] = *reinterpret_cast<const bf16x8*>(&w1); qr[9 + 2 * ax] = *reinterpret_cast<const bf16x8*>(&w2); } }
  const int vb0 = (int)(uintptr_t)V_lds + v_rd_base(lane);
  PG8_LAS unsigned char* l3 = (PG8_LAS unsigned char*)lds; const int wu = __builtin_amdgcn_readfirstlane(wid);
  int offK[2], offV[2], offKR;
#pragma unroll
  for (int i = 0; i < 2; ++i) { const int q = (wid * 2 + i) * 1024 + lane * 16; const int row = q >> 8, colB = (q & 255) ^ ((row & 7) << 4); offK[i] = row * LDK + (colB >> 1);
    const int sub = q >> 9, within = q & 511, kk = (sub >> 2) * 8 + (within >> 6), c = (sub & 3) * 32 + ((within & 63) >> 1), k = (kk & ~0xC) | ((kk & 4) << 1) | ((kk & 8) >> 1); offV[i] = k * LDK + c; }
  { const int q = wid * 1024 + lane * 16; const int row = q >> 7, colB = (q & 127) ^ ((row & 7) << 4); offKR = row * LDKR + (colB >> 1); }
#define SDMA(b, k0) do { _Pragma("unroll") for (int _i = 0; _i < 2; ++_i) { \
      __builtin_amdgcn_global_load_lds((const unsigned*)(Kh + (long)(k0) * LDK + offK[_i]), (PG8_LAS unsigned*)(l3 + 3 * SHM_V + (b) * SHM_K + (wu * 2 + _i) * 1024), 16, 0, 0); \
      __builtin_amdgcn_global_load_lds((const unsigned*)(Vh + (long)(k0) * LDK + offV[_i]), (PG8_LAS unsigned*)(l3 + (b) * SHM_V + (wu * 2 + _i) * 1024), 16, 0, 0); } \
    __builtin_amdgcn_global_load_lds((const unsigned*)(KRh + (long)(k0) * LDKR + offKR), (PG8_LAS unsigned*)(l3 + 3 * SHM_V + 3 * SHM_K + (b) * SHM_KR + wu * 1024), 16, 0, 0); } while (0)
#define SWAIT() asm volatile("s_waitcnt vmcnt(0)" ::: "memory")
#define RESC(a) do { if (__any((a) < 1.f)) { if (hi == 0) al_l[r32] = (a); asm volatile("s_waitcnt lgkmcnt(0)" ::: "memory"); \
    _Pragma("unroll") for (int d = 0; d < 4; ++d) _Pragma("unroll") for (int r = 0; r < 16; ++r) o[d][r] *= al_l[crow(r, hi)]; } } while (0)
  f32x16 pA0, pA1, pB0, pB1; float mnA, mnB, alA, alB; bf16x8 pa0, pa1, pa2, pa3; const int NT = seq / KVBLK;
  int s_prev = 0, s_cur = 1, s_nxt = 2;
#define SGB_QK() do { _Pragma("unroll") for (int i_ = 0; i_ < 24; ++i_) { __builtin_amdgcn_sched_group_barrier(0x008, 1, 0); __builtin_amdgcn_sched_group_barrier(0x100, 1, 0); __builtin_amdgcn_sched_group_barrier(0x002, 4, 0); } } while (0)
#define ABODY(PX0, PX1, mnX, alX, PY0, PY1, alY, jj, LAST) do { \
    SBAR(); qkt(PX0, PX1, K_lds + s_cur * SHM_K, KR_lds + s_cur * SHM_KR, qr, r32, hi); \
    finishSM(PY0, PY1, alY, l_reg, pa0, pa1, pa2, pa3); SGB_QK(); SBAR(); \
    pv_d0(o, vb0 + s_prev * SHM_V, pa0, pa1, pa2, pa3); partialSM(PX0, PX1, m_reg, mnX, alX); \
    SWAIT(); __syncthreads(); \
    RESC(alX); \
    if (!(LAST)) { if ((jj) + 2 < NT) SDMA(s_prev, ((jj) + 2) * KVBLK); \
      const int t_ = s_prev; s_prev = s_cur; s_cur = s_nxt; s_nxt = t_; } } while (0)
  SDMA(0, 0); SDMA(1, KVBLK); SWAIT(); __syncthreads();
  qkt(pA0, pA1, K_lds, KR_lds, qr, r32, hi); partialSM(pA0, pA1, m_reg, mnA, alA);
  SDMA(2, 2 * KVBLK);
  for (int j = 1; j + 1 < NT; j += 2) {
    ABODY(pB0, pB1, mnB, alB, pA0, pA1, alA, j, false);
    ABODY(pA0, pA1, mnA, alA, pB0, pB1, alB, j + 1, false);
  }
  ABODY(pB0, pB1, mnB, alB, pA0, pA1, alA, NT - 1, true);
  finishSM(pB0, pB1, alB, l_reg, pa0, pa1, pa2, pa3); SBAR();
  pv_d0(o, vb0 + s_cur * SHM_V, pa0, pa1, pa2, pa3);
  __syncthreads();
#undef ABODY
  if (hi == 0) li_l[r32] = l_reg; asm volatile("s_waitcnt lgkmcnt(0)" ::: "memory");
  { bf16_t* Ot = (bf16_t*)(lds + wid * 8192);
#pragma unroll
    for (int r = 0; r < 16; ++r) { const int orow = crow(r, hi); const float rl = __builtin_amdgcn_rcpf(li_l[orow]);
#pragma unroll
      for (int d0 = 0; d0 < 4; ++d0) Ot[orow * 128 + d0 * 32 + r32] = (bf16_t)(cvtpk(o[d0][r] * rl, 0.f) & 0xffffu); }
    asm volatile("s_waitcnt lgkmcnt(0)" ::: "memory");
    bf16_t* Ow = Ob + (long)(wid * QBLK) * LDO; const bf16_t* Zw = Zb + (long)(wid * QBLK) * LDO;
#pragma unroll
    for (int i = 0; i < 8; ++i) { const int chunk = i * 64 + lane, row = chunk >> 4, c8 = (chunk & 15) * 8; float ov[8], zv[8];
      ld8bf(Ot + row * 128 + c8, ov); ld8bf(Zw + (long)row * LDO + c8, zv);
#pragma unroll
      for (int e = 0; e < 8; ++e) ov[e] *= zv[e];
      st8bf(Ow + (long)row * LDO + c8, ov); } }
  __syncthreads();
#undef SDMA
#undef SWAIT
#undef RESC
}
}

__device__ __forceinline__ void attn_phase(const Params& p, char* lds) {
  const bf16_t* QR = (const bf16_t*)(p.ws + OFF_QRAW); const bf16_t* KV = (const bf16_t*)(p.ws + OFF_KVRAW); const bf16_t* KR = (const bf16_t*)(p.ws + OFF_KROPE);
  const bf16_t* Z = (const bf16_t*)(p.ws + OFF_Z); bf16_t* OG = (bf16_t*)(p.ws + OFF_OG);
  const int G = gridDim.x, bx = blockIdx.x, vcu = (G % 8 == 0) ? (bx % 8) * (G / 8) + bx / 8 : bx;
  for (int u = vcu; u < NB * 8 * 16; u += G) { const int qb = u & 15, h = (u >> 4) & 7, b = u >> 7; const size_t g0 = (size_t)b * TPB, gq = g0 + CL + qb * 256;
    att::attn_unit(QR + gq * 1536 + h * 192, KV + g0 * 2048 + h * 256, KR + g0 * 64, KV + g0 * 2048 + h * 256 + 128, Z + gq * 1024 + h * 128, OG + gq * 1024 + h * 128, TPB, lds,
                   p.in[25], p.in[26], (const float*)(p.ws + OFF_ROPE), qb * 256, (const float*)(p.ws + OFF_SSQ) + gq); }
}

#define XB_TMO      128
#define XB_XCNT(j)  (256  + 64 * (j))
#define XB_XSUB(j)  (1280 + 64 * (j))
#define XB_XGEN(j)  (2304 + 64 * (j))
#define XB_TOP      3328
#define XB_TOPGEN   3392
#define XCD_BAR_WORDS 3456
#define XB_SPIN_CAP (1u << 18)
#define LAS __attribute__((address_space(3)))

__device__ __forceinline__ unsigned xb_ld(unsigned* p)              { return __hip_atomic_load(p, __ATOMIC_RELAXED, __HIP_MEMORY_SCOPE_AGENT); }
__device__ __forceinline__ unsigned xb_add(unsigned* p, unsigned v) { return __hip_atomic_fetch_add(p, v, __ATOMIC_RELAXED, __HIP_MEMORY_SCOPE_AGENT); }
__device__ __forceinline__ unsigned xb_xcc_id() { return (unsigned)__builtin_amdgcn_s_getreg((3 << 11) | 20) & 0xFu; }
#define XB_SPIN(cond, bar) do { unsigned _sp = 0; while (cond) { __builtin_amdgcn_s_sleep(1); \
    if ((++_sp & 255u) == 0u) { if (xb_ld(&(bar)[XB_TMO])) break; if (_sp > XB_SPIN_CAP) { atomicAdd(&(bar)[XB_TMO], 1u); break; } } } } while (0)

struct XcdBarrier {
    unsigned* bar; unsigned x;
    volatile LAS unsigned* st;
};

__device__ __forceinline__ XcdBarrier xcd_barrier_post(unsigned* bar, volatile LAS unsigned* st) {
    XcdBarrier b; b.bar = bar; b.x = xb_xcc_id(); b.st = st;
    if (threadIdx.x == 0) (void)xb_add(&bar[XB_XCNT(b.x)], 1u);
    return b;
}
__device__ __forceinline__ void xcd_barrier_complete(unsigned* bar, unsigned x, unsigned& nloc, unsigned& nx) {
    const unsigned G = gridDim.x * gridDim.y * gridDim.z;
    unsigned sum, cnt, mine, sp = 0u;
    for (;;) {
        sum = 0u; cnt = 0u; mine = 0u;
#pragma unroll
        for (unsigned j = 0; j < 16; ++j) { const unsigned c = xb_ld(&bar[XB_XCNT(j)]); sum += c; cnt += (c > 0u) ? 1u : 0u; mine = (j == x) ? c : mine; }
        if (sum == G) break;
        __builtin_amdgcn_s_sleep(1);
        if ((++sp & 255u) == 0u) { if (xb_ld(&bar[XB_TMO])) break; if (sp > XB_SPIN_CAP) { atomicAdd(&bar[XB_TMO], 1u); break; } }
    }
    nloc = mine > 0u ? mine : 1u; nx = cnt > 0u ? cnt : 1u;
}

__device__ __forceinline__ void xcd_barrier(const XcdBarrier& b) {
    asm volatile("s_waitcnt vmcnt(0)" ::: "memory");
    __syncthreads();
    if (threadIdx.x == 0) {
        unsigned* bar = b.bar;
        __builtin_amdgcn_s_waitcnt(0);
        unsigned nloc = b.st[0], nx = b.st[1];
        if (nloc == 0u) { xcd_barrier_complete(bar, b.x, nloc, nx); b.st[0] = nloc; b.st[1] = nx; }
        const unsigned old = xb_add(&bar[XB_XSUB(b.x)], 1u);
        const unsigned gen = old / nloc;
        if (old + 1u == (gen + 1u) * nloc) {
            __builtin_amdgcn_fence(__ATOMIC_RELEASE, "agent");
            asm volatile("s_waitcnt vmcnt(0)" ::: "memory");
            const unsigned og = xb_add(&bar[XB_TOP], 1u);
            const unsigned tg = og / nx;
            if (og + 1u == (tg + 1u) * nx) xb_add(&bar[XB_TOPGEN], 1u);
            else XB_SPIN(xb_ld(&bar[XB_TOPGEN]) == tg, bar);
            __builtin_amdgcn_fence(__ATOMIC_ACQUIRE, "agent");
            xb_add(&bar[XB_XGEN(b.x)], 1u);
            asm volatile("s_waitcnt vmcnt(0)" ::: "memory");
        } else {
            XB_SPIN(xb_ld(&bar[XB_XGEN(b.x)]) == gen, bar);
            __builtin_amdgcn_fence(__ATOMIC_ACQUIRE, "agent");
            asm volatile("s_waitcnt vmcnt(0)" ::: "memory");
        }
    }
    __syncthreads();
}


constexpr int LDS_XB_OFF = 155648;
constexpr int LDS_BYTES = LDS_XB_OFF + 256;
#ifndef PHMASK
#define PHMASK 0xFFFF
#endif
#define PH(k) ((PHMASK >> (k)) & 1)
__global__ void __launch_bounds__(512, 2) fwd_megakernel(Params p) {
  extern __shared__ __attribute__((aligned(16))) unsigned char lds[];
  cg::grid_group grid = cg::this_grid();
  PG8_LAS unsigned char* l3 = (PG8_LAS unsigned char*)lds;
  const float* mod = (const float*)(p.ws + OFF_MOD);
  if (threadIdx.x < 4) ((volatile LAS unsigned*)(l3 + LDS_XB_OFF))[threadIdx.x] = 0u;
  __syncthreads();
  XcdBarrier xbar = xcd_barrier_post((unsigned*)(p.ws + OFF_BAR), (volatile LAS unsigned*)(l3 + LDS_XB_OFF));
  if (PH(0)) {
  p0_prologue(p, lds);
  }
  grid.sync();
  if (PH(1)) {
  modnorm_phase(p, 0);
  }
  xcd_barrier(xbar);
  if (PH(2)) {
  { F0 f{(bf16_t*)(p.ws + OFF_CUG), (bf16_t*)(p.ws + OFF_RW), (bf16_t*)(p.ws + OFF_ZB)};
    run_gemm(l3, (const bf16_t*)(p.ws + OFF_H), (const bf16_t*)(p.ws + OFF_W0T), MR, 4352, 1024, f); }
  }
  xcd_barrier(xbar);
  if (PH(3)) {
  rwkv_prep_phase(p);
  }
  xcd_barrier(xbar);
  if (PH(5)) {
  scan_phase(p, lds);
  }
  xcd_barrier(xbar);
  if (PH(6)) {
  even_out_phase(p);
  }
  xcd_barrier(xbar);
  if (PH(7)) {
  { F6 f{(bf16_t*)(p.ws + OFF_DELTA0), mod + 2048};
    run_gemm(l3, (const bf16_t*)(p.ws + OFF_MIX), (const bf16_t*)(p.ws + OFF_WOUT0T), MR, 1024, 1024, f); }
  }
  xcd_barrier(xbar);
  if (PH(8)) {
  modnorm_phase(p, 1);
  }
  xcd_barrier(xbar);
  if (PH(9)) {
  { pg8::Gemm g{(const bf16_t*)(p.ws + OFF_H1), (const bf16_t*)(p.ws + OFF_W1T), MR, 1792, 1024}; pg8::StaticOrder S; S.init(MR, 1792, (int)gridDim.x, (int)blockIdx.x);
    EpiP9 E{p.ws, p.in[22], p.in[28], (PG8_LAS float*)(l3 + 131072)};
    pg8::gemm_phase<EpiP9, pg8::StaticOrder, false>(l3, g, S, E, nullptr); }
  }
  xcd_barrier(xbar);
  if (PH(11)) {
  { FPlain f{(bf16_t*)(p.ws + OFF_QRAW), 1536};
    run_gemm_lat(l3, (const bf16_t*)(p.ws + OFF_P1S), (const bf16_t*)(p.ws + OFF_WQBT), 1536, 384, f); }
  { pg8::Gemm g{(const bf16_t*)(p.ws + OFF_KVAN), (const bf16_t*)(p.ws + OFF_WKVBT), MR, 2048, 256}; pg8::StaticOrder S; S.init(MR, 2048, (int)gridDim.x, (int)blockIdx.x);
    EpiKV E{(bf16_t*)(p.ws + OFF_KVRAW), p.in[27], (PG8_LAS float*)(l3 + 131072)};
    pg8::gemm_phase<EpiKV, pg8::StaticOrder, false>(l3, g, S, E, nullptr); }
  }
  xcd_barrier(xbar);
  if (PH(13)) {
  attn_phase(p, (char*)lds);
  }
  xcd_barrier(xbar);
  if (PH(14)) {
  { F13 f{p.out, p.in[0], (const bf16_t*)(p.ws + OFF_DELTA0), mod + 9 * 3072 + 2048};
    run_gemm_lat(l3, (const bf16_t*)(p.ws + OFF_OG), (const bf16_t*)(p.ws + OFF_WOT), 1024, 1024, f); }
  }
}

extern "C" void kernel_launch(void* const* d_in, const int* in_sizes, int n_in, void* d_out, int out_size, void* d_ws, size_t ws_size, hipStream_t stream) {
  static int grid_blocks = 0;
  if (grid_blocks == 0) {
    if (n_in != 30 || ws_size < WS_NEED || out_size != NB * SEQ * DM) { fprintf(stderr, "kernel_launch: unexpected shapes: n_in %d ws %zu (need %zu) out %d\n", n_in, ws_size, (size_t)WS_NEED, out_size); grid_blocks = -1; return; }
    int dev = 0, cus = 0, per_cu = 0;
    hipGetDevice(&dev); hipDeviceGetAttribute(&cus, hipDeviceAttributeMultiprocessorCount, dev);
    if (hipFuncSetAttribute((const void*)fwd_megakernel, hipFuncAttributeMaxDynamicSharedMemorySize, LDS_BYTES) != hipSuccess) { fprintf(stderr, "kernel_launch: hipFuncSetAttribute failed\n"); grid_blocks = -1; return; }
    hipOccupancyMaxActiveBlocksPerMultiprocessor(&per_cu, (const void*)fwd_megakernel, 512, LDS_BYTES);
    if (per_cu < 1) { fprintf(stderr, "kernel_launch: occupancy query says %d blocks/CU\n", per_cu); per_cu = 1; }
    grid_blocks = cus * 1;
    (void)hipGetLastError();
  }
  if (grid_blocks < 0) return;
  Params p{};
  for (int i = 0; i < 30; ++i) p.in[i] = (const float*)d_in[i];
  p.out = (float*)d_out; p.ws = (unsigned char*)d_ws;
  (void)hipMemsetAsync((unsigned char*)d_ws + OFF_BAR, 0, BAR_BYTES, stream);
  void* args[] = {&p};
  hipError_t e = hipLaunchCooperativeKernel((const void*)fwd_megakernel, dim3(grid_blocks), dim3(512), args, LDS_BYTES, stream);
  if (e != hipSuccess) fprintf(stderr, "cooperative launch failed: %s (grid %d)\n", hipGetErrorString(e), grid_blocks);
}
```

```cpp
#include <hip/hip_runtime.h>
#include <hip/hip_cooperative_groups.h>
#include <cstdio>
namespace cg = cooperative_groups;
__device__ __forceinline__ int opaque_tid() { int t = threadIdx.x; asm volatile("" : "+v"(t)); return t; }
namespace pg8 {
#define PG8_LAS __attribute__((address_space(3)))
typedef unsigned short bf16_t;
typedef short bf16x8 __attribute__((ext_vector_type(8)));
typedef float f32x4 __attribute__((ext_vector_type(4)));
typedef unsigned u32x4 __attribute__((ext_vector_type(4)));
constexpr int BM = 256, BK = 64, HALF = 128, HTB = HALF * BK * 2  , STAGE_BYTES = 8 * HTB, NXCD = 8, WGM = 8;

__host__ __device__ __forceinline__ int lds_byte(int r, int c) { const int st = (r >> 4) * 2 + (c >> 5), rr = r & 15, cc = c & 31, ob = rr * 64 + cc * 2; return st * 1024 + (ob ^ (((ob >> 9) & 1) << 5)); }
__host__ __device__ __forceinline__ void stage_rc(int b, int& R, int& C) { const int st = b / 1024, sb = b % 1024, swz = sb ^ (((sb >> 9) & 1) << 5); R = (st >> 1) * 16 + swz / 64; C = (st & 1) * 32 + (swz % 64) / 2; }
__host__ __device__ __forceinline__ int perm32(int rho) { const int n = rho >> 4, i = rho & 15; return 8 * (i >> 2) + 4 * n + (i & 3); }

struct Unit { int pm, pn; };
struct Gemm { const bf16_t* A; const bf16_t* Bt; int M, N, K; };

struct StaticOrder {
    int nM, nN, nwg, G, c;
    __host__ __device__ void init(int M, int N, int G_, int c_) { nM = M / BM; nN = N / BM; nwg = nM * nN; G = G_; c = c_; }
    __host__ __device__ bool next(int i, Unit& u) const {
        const long L = (long)i * G + c; if (L >= nwg) return false;
        int wgid = (int)L; { const int q = nwg / NXCD, r = nwg % NXCD, xcd = wgid % NXCD, off = wgid / NXCD; wgid = (xcd < r ? xcd * (q + 1) : r * (q + 1) + (xcd - r) * q) + off; }
        const int nig = WGM * nN, gid = wgid / nig, fm = gid * WGM, gsz = (nM - fm) < WGM ? (nM - fm) : WGM;
        u.pm = fm + ((wgid % nig) % gsz); u.pn = (wgid % nig) / gsz; return true;
    }
    __device__ __forceinline__ void a_ready(const Unit&) const {}
    __device__ __forceinline__ void done(const Unit&) const {}
};
struct CountedOrder : StaticOrder {
    const unsigned* ready; unsigned need; unsigned* tmo;
    __device__ __forceinline__ void a_ready(const Unit& u) const {
        if (threadIdx.x < 64) {
            const unsigned long long t0 = __builtin_amdgcn_s_memrealtime(); unsigned polls = 0;
            while ((unsigned)__builtin_amdgcn_readfirstlane(__hip_atomic_load(ready + 64 * u.pm, __ATOMIC_RELAXED, __HIP_MEMORY_SCOPE_AGENT)) < need) {
                if ((++polls & 255u) == 0u && __builtin_amdgcn_readfirstlane(__hip_atomic_load(tmo, __ATOMIC_RELAXED, __HIP_MEMORY_SCOPE_AGENT)) != 0u) break;
                if (__builtin_amdgcn_s_memrealtime() - t0 > 2000000ull) {
                    if (threadIdx.x == 0) { unsigned expect = 0u; __hip_atomic_compare_exchange_strong(tmo + 1, &expect, 0x600u | (unsigned)(u.pm & 0xff), __ATOMIC_RELAXED, __ATOMIC_RELAXED, __HIP_MEMORY_SCOPE_AGENT); __hip_atomic_store(tmo, 1u, __ATOMIC_RELAXED, __HIP_MEMORY_SCOPE_AGENT); }
                    break; }
                __builtin_amdgcn_s_sleep(2); }
            __builtin_amdgcn_fence(__ATOMIC_ACQUIRE, "agent");
            asm volatile("s_waitcnt vmcnt(0)" ::: "memory");
        }
#if !defined(BROKEN_HOOK_NO_BARRIER)
        asm volatile("" ::: "memory"); __builtin_amdgcn_s_barrier(); asm volatile("" ::: "memory");
#endif
    }
};

__device__ __forceinline__ unsigned cvt_pk_bf16(float lo, float hi) { unsigned r; asm volatile("v_cvt_pk_bf16_f32 %0, %1, %2" : "=v"(r) : "v"(lo), "v"(hi)); return r; }
typedef float f32x2 __attribute__((ext_vector_type(2)));
__device__ __forceinline__ f32x2 gelu_pk(f32x2 v) {
    const f32x2 av = __builtin_elementwise_abs(v), d = av * 0.2316418882f + 1.0f;
    f32x2 t; t.x = __builtin_amdgcn_rcpf(d.x); t.y = __builtin_amdgcn_rcpf(d.y);
    f32x2 q = t * 0.5307027145f + (-0.7265760135f); q = q * t + 0.7107068705f; q = q * t + (-0.142248368f); q = q * t + 0.127414796f; q = q * t;
    const f32x2 s = (v * v) * (-0.72134752044f);
    f32x2 e; e.x = __builtin_amdgcn_exp2f(s.x); e.y = __builtin_amdgcn_exp2f(s.y);
    const f32x2 m = v * (q * e), r = v - m;
    f32x2 o; o.x = v.x < 0.f ? m.x : r.x; o.y = v.y < 0.f ? m.y : r.y; return o;
}

struct EpiF32 {
    static constexpr bool PERM = false, AFTER_DRAIN = false;
    float* C; int ldc; const float* bias;
    __device__ __forceinline__ void operator()(const f32x4 (&acc)[2][2][4][2], const Unit& u, int wr, int wc, int fr, int fq) const {
        const int row0 = u.pm * BM + wr * 64 + fr, col0 = u.pn * BM + wc * 32 + 4 * fq;
        f32x4 bv[2][2];
#pragma unroll
        for (int bj = 0; bj < 2; ++bj)
#pragma unroll
            for (int n = 0; n < 2; ++n) bv[bj][n] = bias ? *(const f32x4*)(bias + col0 + bj * HALF + n * 16) : (f32x4){0.f, 0.f, 0.f, 0.f};
#pragma unroll
        for (int ai = 0; ai < 2; ++ai)
#pragma unroll
            for (int m = 0; m < 4; ++m) { float* rowp = C + (size_t)(row0 + ai * HALF + m * 16) * ldc + col0;
#pragma unroll
                for (int bj = 0; bj < 2; ++bj)
#pragma unroll
                    for (int n = 0; n < 2; ++n) *(f32x4*)(rowp + bj * HALF + n * 16) = acc[ai][bj][m][n] + bv[bj][n]; }
    }
};
template <int ACT  > struct EpiBf16 {
    static constexpr bool PERM = true, AFTER_DRAIN = false;
    bf16_t* O; int ldc; const float* bias; int split_cols; size_t split_stride;
    __device__ __forceinline__ void operator()(const f32x4 (&acc)[2][2][4][2], const Unit& u, int wr, int wc, int fr, int fq) const {
        const int row0 = u.pm * BM + wr * 64 + fr; int colt = u.pn * BM; bf16_t* base = O;
        if (split_cols) { const int t = colt / split_cols; base += (size_t)t * split_stride; colt -= t * split_cols; }
        const int col0 = colt + wc * 32 + 8 * fq, bcol0 = u.pn * BM + wc * 32 + 8 * fq;
        f32x4 bv[2][2];
#pragma unroll
        for (int bj = 0; bj < 2; ++bj)
#pragma unroll
            for (int n = 0; n < 2; ++n) bv[bj][n] = bias ? *(const f32x4*)(bias + bcol0 + bj * HALF + 4 * n) : (f32x4){0.f, 0.f, 0.f, 0.f};
#pragma unroll
        for (int ai = 0; ai < 2; ++ai)
#pragma unroll
            for (int m = 0; m < 4; ++m) { bf16_t* rowp = base + (size_t)(row0 + ai * HALF + m * 16) * ldc + col0;
#pragma unroll
                for (int bj = 0; bj < 2; ++bj) { f32x4 v0 = acc[ai][bj][m][0] + bv[bj][0], v1 = acc[ai][bj][m][1] + bv[bj][1];
                    if (ACT == 1) { f32x2 a = gelu_pk((f32x2){v0[0], v0[1]}), b = gelu_pk((f32x2){v0[2], v0[3]}), c = gelu_pk((f32x2){v1[0], v1[1]}), d = gelu_pk((f32x2){v1[2], v1[3]});
                        v0 = (f32x4){a.x, a.y, b.x, b.y}; v1 = (f32x4){c.x, c.y, d.x, d.y}; }
                    if (ACT == 2) {
#pragma unroll
                        for (int j = 0; j < 4; ++j) { v0[j] = 0.5f * v0[j] * (1.0f + erff(v0[j] * 0.70710678f)); v1[j] = 0.5f * v1[j] * (1.0f + erff(v1[j] * 0.70710678f)); } }
                    u32x4 w; w.x = cvt_pk_bf16(v0[0], v0[1]); w.y = cvt_pk_bf16(v0[2], v0[3]); w.z = cvt_pk_bf16(v1[0], v1[1]); w.w = cvt_pk_bf16(v1[2], v1[3]);
                    *(u32x4*)(rowp + bj * HALF) = w; } }
    }
};

template <class Epi, class Sched, bool STAMP = false>
__device__ __forceinline__ void gemm_phase(PG8_LAS unsigned char* lds, const Gemm g, const Sched& S, const Epi& E, unsigned long long* stamps) {
    const int tid = opaque_tid(), wid = __builtin_amdgcn_readfirstlane(tid >> 6), lane = tid & 63, wr = wid >> 2, wc = wid & 3, fr = lane & 15, fq = lane >> 4;
    const int K = g.K, nt = K / BK;
    int ts_lo = 0, ts_hi = 0, nts = 0; const unsigned long long rt_entry = STAMP ? (unsigned long long)wall_clock64() : 0ull;
#define PG8_STAMP() do { if (STAMP && wid == 0 && nts < 64) { const unsigned long long _c = (unsigned long long)clock64(); \
        ts_lo = (lane == nts) ? (int)(unsigned)_c : ts_lo; ts_hi = (lane == nts) ? (int)(unsigned)(_c >> 32) : ts_hi; ++nts; } } while (0)
    PG8_STAMP();
    unsigned voffA[2], voffB[2];
#pragma unroll
    for (int i = 0; i < 2; ++i) { int R, C; stage_rc(tid * 16 + i * 8192, R, C); const int Rb = Epi::PERM ? ((R & ~31) + perm32(R & 31)) : R;
        voffA[i] = (unsigned)(R * K + C) * 2u; voffB[i] = (unsigned)(Rb * K + C) * 2u; }
    const size_t kstep = (size_t)(BK * 2);
    const size_t hstep = (size_t)HALF * K * 2;
    const size_t tstep = 2 * hstep;
    const unsigned ldsw = (unsigned)wid * 1024u;
    const int aoff = lds_byte(wr * 64 + fr, fq * 8), boff = lds_byte(wc * 32 + fr, fq * 8);
#define PG8_SA(b, h) (((b) * 2 + (h)) * HTB)
#define PG8_SB(b, h) ((4 + (b) * 2 + (h)) * HTB)
#define PG8_STAGE(bufoff, gbase, voff) do { _Pragma("unroll") for (int _i = 0; _i < 2; ++_i) \
        __builtin_amdgcn_global_load_lds((const unsigned*)((const char*)(gbase) + (voff)[_i]), (PG8_LAS unsigned*)(lds + (bufoff) + ldsw + _i * 8192), 16, 0, 0); } while (0)
#define PG8_LDA(dst, b, h) do { _Pragma("unroll") for (int m = 0; m < 4; ++m) _Pragma("unroll") for (int k = 0; k < 2; ++k) dst[m][k] = *(const PG8_LAS bf16x8*)(lds + PG8_SA(b, h) + aoff + m * 2048 + k * 1024); } while (0)
#define PG8_LDB(dst, b, h) do { _Pragma("unroll") for (int n = 0; n < 2; ++n) _Pragma("unroll") for (int k = 0; k < 2; ++k) dst[n][k] = *(const PG8_LAS bf16x8*)(lds + PG8_SB(b, h) + boff + n * 2048 + k * 1024); } while (0)
#define PG8_MMA(ai, bj, At, Bt) do { __builtin_amdgcn_s_setprio(1); _Pragma("unroll") for (int m = 0; m < 4; ++m) _Pragma("unroll") for (int n = 0; n < 2; ++n) _Pragma("unroll") for (int k = 0; k < 2; ++k) \
        acc[ai][bj][m][n] = __builtin_amdgcn_mfma_f32_16x16x32_bf16(Bt[n][k], At[m][k], acc[ai][bj][m][n], 0, 0, 0); __builtin_amdgcn_s_setprio(0); } while (0)
#define PG8_WAIT_V(n) asm volatile("s_waitcnt vmcnt(" #n ")" ::: "memory")
#define PG8_WAIT_L(n) asm volatile("s_waitcnt lgkmcnt(" #n ")" ::: "memory")
#define PG8_BAR __builtin_amdgcn_s_barrier()
#define PG8_SCHED __builtin_amdgcn_sched_barrier(0)
    Unit cur, nxt; int ui = 0;
    if (!S.next(0, cur)) return;
    f32x4 acc[2][2][4][2];
#pragma unroll
    for (int a = 0; a < 2; ++a)
#pragma unroll
        for (int b = 0; b < 2; ++b)
#pragma unroll
            for (int m = 0; m < 4; ++m)
#pragma unroll
                for (int n = 0; n < 2; ++n) acc[a][b][m][n] = (f32x4){0.f, 0.f, 0.f, 0.f};
    bf16x8 At[4][2], B0[2][2], B1[2][2];
    const char* cA = (const char*)g.A + (size_t)cur.pm * tstep; const char* cB = (const char*)g.Bt + (size_t)cur.pn * tstep;
    S.a_ready(cur);
    PG8_STAGE(PG8_SB(0, 0), cB, voffB); PG8_STAGE(PG8_SA(0, 0), cA, voffA); PG8_STAGE(PG8_SB(0, 1), cB + hstep, voffB); PG8_STAGE(PG8_SA(0, 1), cA + hstep, voffA);
    if (wr == 1) PG8_BAR;
    PG8_WAIT_V(4); PG8_BAR;
    PG8_STAGE(PG8_SB(1, 0), cB + kstep, voffB); PG8_STAGE(PG8_SA(1, 0), cA + kstep, voffA); PG8_STAGE(PG8_SB(1, 1), cB + hstep + kstep, voffB);
    PG8_WAIT_V(6); PG8_BAR;
    PG8_STAMP();
    for (;;) {
        const bool has_next = S.next(ui + 1, nxt);
        const char* nA = has_next ? (const char*)g.A + (size_t)nxt.pm * tstep : cA; const char* nB = has_next ? (const char*)g.Bt + (size_t)nxt.pn * tstep : cB;
#pragma unroll 1
        for (int t = 0; t < nt; t += 2) {
            const bool last = (t == nt - 2);
            const char* a1 = cA + (size_t)(t + 1) * kstep;
            const char* a2 = last ? nA : cA + (size_t)(t + 2) * kstep; const char* b2 = last ? nB : cB + (size_t)(t + 2) * kstep;
            const char* a3 = a2 + kstep; const char* b3 = b2 + kstep;
            if (last && has_next) S.a_ready(nxt);
            PG8_LDB(B0, 0, 0); PG8_SCHED; PG8_LDA(At, 0, 0); PG8_STAGE(PG8_SA(1, 1), a1 + hstep, voffA);
            PG8_WAIT_L(8); PG8_BAR; PG8_WAIT_L(0); PG8_MMA(0, 0, At, B0); PG8_BAR; PG8_SCHED;
            PG8_LDB(B1, 0, 1); PG8_STAGE(PG8_SB(0, 0), b2, voffB);
            PG8_BAR; PG8_WAIT_L(0); PG8_MMA(0, 1, At, B1); PG8_BAR;
            PG8_LDA(At, 0, 1); PG8_STAGE(PG8_SA(0, 0), a2, voffA);
            PG8_BAR; PG8_WAIT_L(0); PG8_MMA(1, 0, At, B0); PG8_BAR; PG8_SCHED;
            PG8_STAGE(PG8_SB(0, 1), b2 + hstep, voffB);
            PG8_WAIT_V(6); PG8_BAR; PG8_MMA(1, 1, At, B1); PG8_BAR;
            PG8_LDB(B0, 1, 0); PG8_SCHED; PG8_LDA(At, 1, 0); PG8_STAGE(PG8_SA(0, 1), a2 + hstep, voffA);
            PG8_WAIT_L(8); PG8_BAR; PG8_WAIT_L(0); PG8_MMA(0, 0, At, B0); PG8_BAR; PG8_SCHED;
            PG8_LDB(B1, 1, 1); PG8_STAGE(PG8_SB(1, 0), b3, voffB);
            PG8_BAR; PG8_WAIT_L(0); PG8_MMA(0, 1, At, B1); PG8_BAR;
            PG8_LDA(At, 1, 1); PG8_STAGE(PG8_SA(1, 0), a3, voffA);
            PG8_BAR; PG8_WAIT_L(0); PG8_MMA(1, 0, At, B0); PG8_BAR; PG8_SCHED;
            PG8_STAGE(PG8_SB(1, 1), b3 + hstep, voffB);
            PG8_WAIT_V(6); PG8_BAR; PG8_MMA(1, 1, At, B1); PG8_BAR;
        }
        PG8_STAMP();
        if constexpr (!Epi::AFTER_DRAIN) { E(acc, cur, wr, wc, fr, fq); S.done(cur); }
        PG8_STAMP();
        if (!has_next) break;
#pragma unroll
        for (int a = 0; a < 2; ++a)
#pragma unroll
            for (int b = 0; b < 2; ++b)
#pragma unroll
                for (int m = 0; m < 4; ++m)
#pragma unroll
                    for (int n = 0; n < 2; ++n) acc[a][b][m][n] = (f32x4){0.f, 0.f, 0.f, 0.f};
        cur = nxt; cA = nA; cB = nB; ++ui;
    }
    PG8_WAIT_V(0);
    if (wr == 0) PG8_BAR;
    PG8_BAR;
    if constexpr (Epi::AFTER_DRAIN) { E.fused(acc, cur, wr, wc, fr, fq, lds, wid, lane); S.done(cur); }
    PG8_STAMP();
    if (STAMP && wid == 0) { stamps[lane] = lane < nts ? (((unsigned long long)(unsigned)ts_hi << 32) | (unsigned)ts_lo) : 0ull;
        if (lane == 62) stamps[62] = rt_entry; if (lane == 63) stamps[63] = (unsigned long long)wall_clock64(); }
#undef PG8_STAMP
#undef PG8_SA
#undef PG8_SB
#undef PG8_STAGE
#undef PG8_LDA
#undef PG8_LDB
#undef PG8_MMA
#undef PG8_WAIT_V
#undef PG8_WAIT_L
#undef PG8_BAR
#undef PG8_SCHED
}
}

typedef unsigned short bf16_t;
typedef short bf16x8 __attribute__((ext_vector_type(8)));
typedef short s16x4 __attribute__((ext_vector_type(4)));
typedef float f32x4 __attribute__((ext_vector_type(4)));
typedef float f32x16 __attribute__((ext_vector_type(16)));
typedef unsigned u32x4 __attribute__((ext_vector_type(4)));
typedef unsigned u32x2 __attribute__((ext_vector_type(2)));
typedef float f32x2 __attribute__((ext_vector_type(2)));
typedef _Float16 h16x8 __attribute__((ext_vector_type(8)));
typedef _Float16 h16x4 __attribute__((ext_vector_type(4)));

constexpr int NB = 8, SEQ = 4096, CL = 256, DM = 1024, TPB = 4352  , MR = NB * TPB  ;
constexpr float SM_SCALE = 0.07216878364870322f;

constexpr size_t OFF_W0T = 0, OFF_WLT = 8912896, OFF_WOUT0T = 9961472, OFF_W1T = 12058624, OFF_WQBT = 15728640, OFF_WKVBT = 16908288, OFF_WOT = 17956864,
                 OFF_MOD = 20054016, OFF_R1 = 20275200;
constexpr size_t SZ_M512_2 = (size_t)MR * 512 * 2  , SZ_M1024_2 = (size_t)MR * 1024 * 2  ;
constexpr size_t OFF_H = OFF_R1, OFF_E16 = OFF_R1  , OFF_MIX = OFF_R1 + SZ_M1024_2, OFF_DELTA0 = OFF_R1;
constexpr size_t OFF_R2 = OFF_R1 + (size_t)MR * 1024 * 4  , OFF_RW = OFF_R2  ;
constexpr size_t OFF_R3 = OFF_R2 + (size_t)MR * 1664 * 2, OFF_CUG = OFF_R3, OFF_ZB = OFF_R3 + SZ_M1024_2;
constexpr size_t OFF_R4 = OFF_R3 + SZ_M1024_2 + SZ_M512_2, OFF_IC16 = OFF_R4  ;
constexpr size_t OFF_R5 = OFF_R4 + SZ_M1024_2, OFF_Y16 = OFF_R5  , OFF_LA = OFF_R4  ;
constexpr size_t WS_NEED0 = OFF_R5 + SZ_M1024_2;
constexpr size_t OFF_H1 = OFF_R1 + SZ_M1024_2, OFF_QAN = OFF_H1, OFF_OG = OFF_H1;
constexpr size_t OFF_Z = OFF_R2, OFF_P1S = OFF_R2 + SZ_M1024_2  , OFF_QRAW = OFF_P1S + (size_t)MR * 384 * 2  , OFF_KVRAW = OFF_QRAW + (size_t)MR * 1536 * 2, OFF_KROPE = OFF_KVRAW + (size_t)MR * 2048 * 2;
constexpr size_t OFF_KVAN = OFF_KROPE + (size_t)MR * 64 * 2;
constexpr size_t OFF_SSQ = OFF_KVAN + (size_t)MR * 256 * 2;
constexpr size_t WS_NEED1 = OFF_SSQ + (size_t)MR * 4;
constexpr size_t OFF_BAR = WS_NEED0 > WS_NEED1 ? WS_NEED0 : WS_NEED1;
constexpr size_t BAR_BYTES = 16384;
constexpr size_t OFF_ROPE = OFF_BAR + BAR_BYTES;
constexpr size_t OFF_TS = OFF_ROPE + 8192;
constexpr size_t WS_NEED = OFF_TS + (size_t)2 * MR * 8 * 4;
static_assert(WS_NEED <= 536870912, "workspace2");
static_assert(WS_NEED <= 536870912, "workspace");
static_assert(OFF_R1 % 256 == 0 && OFF_R2 % 256 == 0 && OFF_R3 % 256 == 0, "align");

struct Params { const float* in[30]; float* out; unsigned char* ws; };

__device__ __forceinline__ unsigned cvtpk(float lo, float hi) { unsigned r; asm("v_cvt_pk_bf16_f32 %0, %1, %2" : "=v"(r) : "v"(lo), "v"(hi)); return r; }
__device__ __forceinline__ u32x4 pack8(const float (&v)[8]) { return (u32x4){cvtpk(v[0], v[1]), cvtpk(v[2], v[3]), cvtpk(v[4], v[5]), cvtpk(v[6], v[7])}; }
__device__ __forceinline__ void unpack8(u32x4 w, float (&v)[8]) {
  v[0] = __uint_as_float(w.x << 16); v[1] = __uint_as_float(w.x & 0xffff0000u); v[2] = __uint_as_float(w.y << 16); v[3] = __uint_as_float(w.y & 0xffff0000u);
  v[4] = __uint_as_float(w.z << 16); v[5] = __uint_as_float(w.z & 0xffff0000u); v[6] = __uint_as_float(w.w << 16); v[7] = __uint_as_float(w.w & 0xffff0000u); }
__device__ __forceinline__ void ld8bf(const bf16_t* p, float (&v)[8]) { unpack8(*(const u32x4*)p, v); }
__device__ __forceinline__ void st8bf(bf16_t* p, const float (&v)[8]) { *(u32x4*)p = pack8(v); }
__device__ __forceinline__ void ld8f(const float* p, float (&v)[8]) { const f32x4 a = *(const f32x4*)p, b = *(const f32x4*)(p + 4); v[0] = a[0]; v[1] = a[1]; v[2] = a[2]; v[3] = a[3]; v[4] = b[0]; v[5] = b[1]; v[6] = b[2]; v[7] = b[3]; }
__device__ __forceinline__ void ld8h(const _Float16* p, float (&v)[8]) { const h16x8 a = *(const h16x8*)p;
#pragma unroll
  for (int i = 0; i < 8; ++i) v[i] = (float)a[i]; }
__device__ __forceinline__ float sigmoidf_(float x) { return __builtin_amdgcn_rcpf(1.f + __expf(-x)); }
__device__ __forceinline__ float siluf_(float x) { return x * sigmoidf_(x); }
__device__ __forceinline__ f32x4 silu4(f32x4 x) { return (f32x4){siluf_(x[0]), siluf_(x[1]), siluf_(x[2]), siluf_(x[3])}; }
__device__ __forceinline__ void st8(bf16_t* d, f32x4 a, f32x4 b) { *(u32x4*)d = (u32x4){cvtpk(a[0], a[1]), cvtpk(a[2], a[3]), cvtpk(b[0], b[1]), cvtpk(b[2], b[3])}; }
template <int CTRL> __device__ __forceinline__ float dppmov(float v) { return __int_as_float(__builtin_amdgcn_update_dpp(0, __float_as_int(v), CTRL, 0xF, 0xF, true)); }
__device__ __forceinline__ float red8(float x) { x += dppmov<0xB1>(x); x += dppmov<0x4E>(x); x += dppmov<0x141>(x); return x; }
__device__ __forceinline__ float wave_sum(float x) {
#pragma unroll
  for (int o = 32; o >= 1; o >>= 1) x += __shfl_xor(x, o);
  return x; }

template <class F> struct EpiT { static constexpr bool PERM = true, AFTER_DRAIN = false; F f;
  __device__ __forceinline__ void operator()(const f32x4 (&acc)[2][2][4][2], const pg8::Unit& u, int wr, int wc, int fr, int fq) const {
    const int c = wc * 32 + 8 * fq;
#pragma unroll
    for (int ai = 0; ai < 2; ++ai)
#pragma unroll
      for (int m = 0; m < 4; ++m) { const int row = u.pm * 256 + ai * 128 + wr * 64 + m * 16 + fr;
        f(row, u.pn, c, acc[ai][0][m][0], acc[ai][0][m][1], acc[ai][1][m][0], acc[ai][1][m][1]); } } };

struct LatOrder : pg8::StaticOrder {
  __device__ bool next(int i, pg8::Unit& u) const { const bool ok = pg8::StaticOrder::next(i, u); u.pm = (u.pm >> 4) * 17 + 1 + (u.pm & 15); return ok; } };
template <class F> __device__ __forceinline__ void run_gemm_lat(PG8_LAS unsigned char* lds, const bf16_t* A, const bf16_t* Bt, int N_, int K_, const F& f) {
  pg8::Gemm g{A, Bt, MR, N_, K_}; LatOrder S; S.init(NB * SEQ, N_, (int)gridDim.x, (int)blockIdx.x);
  EpiT<F> E{f};
  pg8::gemm_phase<EpiT<F>, LatOrder, false>(lds, g, S, E, nullptr);
}
template <class F> __device__ __forceinline__ void run_gemm(PG8_LAS unsigned char* lds, const bf16_t* A, const bf16_t* Bt, int M_, int N_, int K_, const F& f) {
  pg8::Gemm g{A, Bt, M_, N_, K_}; pg8::StaticOrder S; S.init(M_, N_, (int)gridDim.x, (int)blockIdx.x);
  EpiT<F> E{f};
  pg8::gemm_phase<EpiT<F>, pg8::StaticOrder, false>(lds, g, S, E, nullptr);
}

template <class MapF> __device__ __forceinline__ void transpose_w(const float* __restrict__ W, int K, int N, bf16_t* __restrict__ Wt, int Nout, MapF map, int gtid, int gn) {
  const int total = Nout * (K / 8);
#pragma unroll 4
  for (int q = gtid; q < total; q += gn) { const int n = q % Nout, k8 = q / Nout; const int src = map(n); float v[8];
#pragma unroll
    for (int i = 0; i < 8; ++i) v[i] = src >= 0 ? W[(size_t)(k8 * 8 + i) * N + src] : 0.f;
    st8bf(Wt + (size_t)n * K + k8 * 8, v); }
}
__device__ __forceinline__ int wsrc_col(int id, int n) {
  if (id == 0) { const int pn = n >> 8, c = n & 255, half = c >> 7, ci = c & 127;
    if (pn < 4) return half ? 1024 + 128 * pn + ci : 128 * pn + ci;
    if (pn < 8) return half ? 1536 + 128 * (pn - 4) + ci : 512 + 128 * (pn - 4) + ci;
    if (pn < 14) return 2048 + 256 * (pn - 8) + c;
    if (pn == 14) return half ? 3712 + ci : 3584 + ci;
    if (pn == 15) return 3840 + c;
    return half ? -1 : 4096 + ci; }
  if (id == 2) return n < 384 ? n : (n < 448 ? 640 + (n - 384) : (n < 512 ? -1 : (n < 768 ? 384 + (n - 512) : n - 64)));
  return n; }
__device__ __forceinline__ void transpose_tile(const float* __restrict__ W, int K, int N, bf16_t* __restrict__ Wt, int id, int tile, bf16_t* T, int tid, const float* __restrict__ kgain = nullptr) {
  const int nkt = K >> 6, n0 = (tile / nkt) << 6, k0 = (tile % nkt) << 6, src0 = wsrc_col(id, n0);
  const int kr = tid >> 4, c4 = (tid & 15) * 4;
#pragma unroll
  for (int pz = 0; pz < 2; ++pz) { const int k = k0 + pz * 32 + kr; f32x4 v = {0.f, 0.f, 0.f, 0.f};
    if (src0 >= 0) v = *(const f32x4*)(W + (size_t)k * N + src0 + c4);
    if (kgain) v = v * kgain[k];
    const unsigned lo = cvtpk(v[0], v[1]), hi = cvtpk(v[2], v[3]);
    T[(c4 + 0) * 72 + pz * 32 + kr] = (bf16_t)(lo & 0xffffu); T[(c4 + 1) * 72 + pz * 32 + kr] = (bf16_t)(lo >> 16);
    T[(c4 + 2) * 72 + pz * 32 + kr] = (bf16_t)(hi & 0xffffu); T[(c4 + 3) * 72 + pz * 32 + kr] = (bf16_t)(hi >> 16); }
  __syncthreads();
  { const int n = tid >> 3, k8 = (tid & 7) * 8; *(u32x4*)(Wt + (size_t)(n0 + n) * K + k0 + k8) = *(const u32x4*)(T + n * 72 + k8); }
  __syncthreads();
}
__device__ __forceinline__ void p0_prologue(const Params& p, unsigned char* ldsg) {
  const int tid = opaque_tid(), wid = tid >> 6, lane = tid & 63;
  float* sc = (float*)ldsg; float* red = sc + 9 * 1024;
  float* mod = (float*)(p.ws + OFF_MOD);
  for (int it = blockIdx.x; it < 96; it += gridDim.x) {
    for (int i = tid; i < 9 * 1024; i += 512) { const int bb = i >> 10, k = i & 1023; const float c = bb < 8 ? p.in[1][bb * 1024 + k] : p.in[3][k]; sc[i] = siluf_(c); }
    __syncthreads();
    const int l = it / 48, n0 = (it % 48) * 64; const float* W = p.in[4] + (size_t)l * 1024 * 3072 + n0 + lane; const int k0 = wid * 128;
    float acc[9];
#pragma unroll
    for (int bb = 0; bb < 9; ++bb) acc[bb] = 0.f;
#pragma unroll 16
    for (int k = 0; k < 128; ++k) { const float w = W[(size_t)(k0 + k) * 3072];
#pragma unroll
      for (int bb = 0; bb < 9; ++bb) acc[bb] += sc[bb * 1024 + k0 + k] * w; }
#pragma unroll
    for (int bb = 0; bb < 9; ++bb) red[(wid * 9 + bb) * 64 + lane] = acc[bb];
    __syncthreads();
    for (int i = tid; i < 9 * 64; i += 512) { const int bb = i >> 6, ln = i & 63; float s = 0.f;
#pragma unroll
      for (int w = 0; w < 8; ++w) s += red[(w * 9 + bb) * 64 + ln];
      mod[(l * 9 + bb) * 3072 + n0 + ln] = s + p.in[5][l * 3072 + n0 + ln]; }
    __syncthreads();
  }
  const int gtid = blockIdx.x * 512 + tid, gn = gridDim.x * 512;
  { bf16_t* T = (bf16_t*)(ldsg + 65536);
    auto do_tile = [&](int t) {
      if (t < 1088) transpose_tile(p.in[7], 1024, 4224, (bf16_t*)(p.ws + OFF_W0T), 0, t, T, tid);
      else if (t < 1344) transpose_tile(p.in[19], 1024, 1024, (bf16_t*)(p.ws + OFF_WOUT0T), 1, t - 1088, T, tid);
      else if (t < 1792) transpose_tile(p.in[20], 1024, 1728, (bf16_t*)(p.ws + OFF_W1T), 2, t - 1344, T, tid);
      else if (t < 1936) transpose_tile(p.in[23], 384, 1536, (bf16_t*)(p.ws + OFF_WQBT), 3, t - 1792, T, tid, p.in[21]);
      else if (t < 2064) transpose_tile(p.in[24], 256, 2048, (bf16_t*)(p.ws + OFF_WKVBT), 4, t - 1936, T, tid);
      else transpose_tile(p.in[29], 1024, 1024, (bf16_t*)(p.ws + OFF_WOT), 5, t - 2064, T, tid); };
    const int w = blockIdx.x, G = gridDim.x;
    if (G >= 256) { if (w < 96) { for (int t = w; t < 2320; t += 576) do_tile(t); }
                    else if (w < 256) { for (int j = 0; j < 3; ++j) for (int t = 96 + (w - 96) + j * 160; t < 2320; t += 576) do_tile(t); } }
    else for (int t = w; t < 2320; t += G) do_tile(t); }
  { float* tab = (float*)(p.ws + OFF_ROPE);
    for (int i = gtid; i < 1024; i += gn) { const int idx = i >> 4, pr = i & 15; const float inv = exp2f(-(float)pr * (13.287712379549449f / 16.f)); float sn, cs; sincosf((float)idx * inv, &sn, &cs);
      tab[i * 2] = cs; tab[i * 2 + 1] = sn; } }
}

__device__ __forceinline__ const float* xin_row(const Params& p, int g) { const int b = g / TPB, pos = g - b * TPB;
  return pos < CL ? p.in[2] + (size_t)(b * CL + pos) * DM : p.in[0] + (size_t)(b * SEQ + pos - CL) * DM; }
__device__ __forceinline__ void modnorm_phase(const Params& p, int l) {
  const int tid_ = opaque_tid(), wid = tid_ >> 6, lane = tid_ & 63, gw = blockIdx.x * 8 + wid, nw = gridDim.x * 8;
  const float* mod = (const float*)(p.ws + OFF_MOD); const float* nwp = p.in[6] + l * 1024;
  bf16_t* H = (bf16_t*)(p.ws + (l ? OFF_H1 : OFF_H)); const bf16_t* D0 = (const bf16_t*)(p.ws + OFF_DELTA0);
  for (int g = gw; g < MR; g += nw) { const int b = g / TPB, pos = g - b * TPB, bb = pos < CL ? 8 : b; const float* src = xin_row(p, g);
    f32x4 v[4]; float ss = 0.f;
#pragma unroll
    for (int i = 0; i < 4; ++i) { v[i] = *(const f32x4*)(src + i * 256 + lane * 4);
      if (l) { const u32x2 d = *(const u32x2*)(D0 + (size_t)g * 1024 + i * 256 + lane * 4);
        v[i][0] += __uint_as_float(d.x << 16); v[i][1] += __uint_as_float(d.x & 0xffff0000u); v[i][2] += __uint_as_float(d.y << 16); v[i][3] += __uint_as_float(d.y & 0xffff0000u); }
      ss += v[i][0] * v[i][0] + v[i][1] * v[i][1] + v[i][2] * v[i][2] + v[i][3] * v[i][3]; }
    ss = wave_sum(ss); const float rstd = rsqrtf(ss * (1.f / 1024.f) + 1e-6f); const float* md = mod + (l * 9 + bb) * 3072;
    if (l && lane == 0) ((float*)(p.ws + OFF_SSQ))[g] = 0.f;
#pragma unroll
    for (int i = 0; i < 4; ++i) { const int col = i * 256 + lane * 4; const f32x4 w = *(const f32x4*)(nwp + col), sh = *(const f32x4*)(md + col), sl = *(const f32x4*)(md + 1024 + col);
      const f32x4 h = v[i] * rstd * w * (sl + 1.f) + sh; *(u32x2*)(H + (size_t)g * 1024 + col) = (u32x2){cvtpk(h[0], h[1]), cvtpk(h[2], h[3])}; } }
}

struct F0 { bf16_t* CUG; bf16_t* RW; bf16_t* ZB;
  __device__ __forceinline__ void operator()(int row, int pn, int c, f32x4 a0, f32x4 a1, f32x4 b0, f32x4 b1) const {
    if (pn < 4) st8(CUG + (size_t)row * 1024 + 128 * pn + c, a0 * b0, a1 * b1);
    else if (pn < 8) st8(CUG + (size_t)row * 1024 + 512 + 128 * (pn - 4) + c, a0 * silu4(b0), a1 * silu4(b1));
    else if (pn < 14) { bf16_t* d = RW + (size_t)row * 1664 + 256 * (pn - 8) + c; st8(d, a0, a1); st8(d + 128, b0, b1); }
    else if (pn == 14) { st8(RW + (size_t)row * 1664 + 1536 + c, a0, a1); st8(ZB + (size_t)row * 512 + c, silu4(b0), silu4(b1)); }
    else if (pn == 15) { st8(ZB + (size_t)row * 512 + 128 + c, silu4(a0), silu4(a1)); st8(ZB + (size_t)row * 512 + 256 + c, silu4(b0), silu4(b1)); }
    else st8(ZB + (size_t)row * 512 + 384 + c, silu4(a0), silu4(a1)); } };

__device__ __forceinline__ void rwkv_prep_phase(const Params& p) {
  const int tid_ = opaque_tid(), wid = tid_ >> 6, lane = tid_ & 63, gw = blockIdx.x * 8 + wid, nw = gridDim.x * 8, sub = lane & 15;
  const bf16_t* RW = (const bf16_t*)(p.ws + OFF_RW); bf16_t* LA = (bf16_t*)(p.ws + OFF_LA);
  float m[8]; ld8f(p.in[9] + 1536 + sub * 8, m);
  for (int g = gw * 4 + (lane >> 4); g < MR; g += nw * 4) { const int pos = g % TPB; const bool hp = (pos != 0 && pos != CL), hn = (pos != CL - 1 && pos != TPB - 1);
    const bf16_t* cur = RW + (size_t)g * 1664 + 1536 + sub * 8; float c[8], pv[8], nx[8], o[8], z[8];
    ld8bf(cur, c); ld8bf(hp ? cur - 1664 : cur, pv); ld8bf(hn ? cur + 1664 : cur, nx);
#pragma unroll
    for (int i = 0; i < 8; ++i) { const float pvv = hp ? pv[i] : 0.f, nxv = hn ? nx[i] : 0.f; o[i] = c[i] + m[i] * (0.5f * (pvv + nxv) - c[i]); if (sub < 8) o[i] = tanhf(o[i]); z[i] = 0.f; }
    st8bf(LA + (size_t)g * 256 + sub * 8, o); st8bf(LA + (size_t)g * 256 + 128 + sub * 8, z); }
}

struct FL { _Float16* E0; _Float16* E1; _Float16* I0; _Float16* I1; const float* w0; const float* a0;
  __device__ __forceinline__ void operator()(int row, int pn, int c, f32x4 x0, f32x4 x1, f32x4 y0, f32x4 y1) const {
    const int dir = pn >> 2, kind = (pn >> 1) & 1, cb = 256 * (pn & 1) + c; const float* bias = (kind ? a0 : w0) + dir * 512; const float scl = kind ? 1.f : 0.6065306597126334f;
    _Float16* dst = E0 + (size_t)kind * (size_t)(I0 - E0) + (size_t)dir * ((size_t)MR * 512) + (size_t)row * 512 + cb; float bs[8]; h16x8 o;
    ld8f(bias + cb, bs);
#pragma unroll
    for (int i = 0; i < 4; ++i) { o[i] = (_Float16)(scl * sigmoidf_(bs[i] + x0[i])); o[4 + i] = (_Float16)(scl * sigmoidf_(bs[4 + i] + x1[i])); }
    *(h16x8*)dst = o;
    ld8f(bias + cb + 128, bs);
#pragma unroll
    for (int i = 0; i < 4; ++i) { o[i] = (_Float16)(scl * sigmoidf_(bs[i] + y0[i])); o[4 + i] = (_Float16)(scl * sigmoidf_(bs[4 + i] + y1[i])); }
    *(h16x8*)(dst + 128) = o; asm volatile("" ::: "memory"); } };

constexpr int SC_CH = 32  , SC_STEP = 352  , SC_BUF = SC_CH * SC_STEP * 4  , SC_NCH = TPB / SC_CH  ;
__device__ __forceinline__ int scan_pos(int d, int sg) { return d == 0 ? sg : (sg < CL ? CL - 1 - sg : TPB + CL - 1 - sg); }
__device__ __forceinline__ void scan_phase(const Params& p, unsigned char* ldsg) {
  const int tid = opaque_tid(), wid = tid >> 6, lane = tid & 63;
  _Float16* ypart = (_Float16*)(ldsg + 2 * SC_BUF);
  float* eic = (float*)(ldsg + 2 * SC_BUF + 32768);
  const bf16_t* RW = (const bf16_t*)(p.ws + OFF_RW);
  for (int item = blockIdx.x; item < 256; item += gridDim.x) {
    const int chain = item >> 1, rh = item & 1, b = chain >> 4, h = (chain >> 1) & 7, d = chain & 1;
    const _Float16* E = (const _Float16*)(p.ws + OFF_E16 + (size_t)d * SZ_M512_2); const _Float16* IC = (const _Float16*)(p.ws + OFF_IC16 + (size_t)d * SZ_M512_2);
    _Float16* Y = (_Float16*)(p.ws + OFF_Y16 + (size_t)d * SZ_M512_2);
    const int tl = tid - 256, ls = tl >> 3, j8 = (tl & 7) * 8; float ka[8];
    float rkv[8], kkw[8]; float* TS = (float*)(p.ws + OFF_TS) + (size_t)d * MR * 8;

    u32x4 g_c[3], g_p[3], g_n[3]; bool g_hp = false, g_hn = false;
    const int lkind = (wid >> 1) & 1, lnb = wid & 1, lr32 = lane & 31, lhi = lane >> 5; bf16x8 lB[4], lA[4]; float lbias = 0.f;
    const bf16_t* LAp = (const bf16_t*)(p.ws + OFF_LA);
    if (wid >= 4) { const float* W = (lkind ? p.in[15] : p.in[13]) + (size_t)d * 64 * 512 + h * 64 + lnb * 32 + lr32;
#pragma unroll
      for (int kk = 0; kk < 4; ++kk) { float f[8];
#pragma unroll
        for (int e2 = 0; e2 < 8; ++e2) f[e2] = W[(size_t)(kk * 16 + lhi * 8 + e2) * 512];
        const u32x4 pk = pack8(f); lB[kk] = *reinterpret_cast<const bf16x8*>(&pk); }
      lbias = (lkind ? p.in[14] : p.in[12])[d * 512 + h * 64 + lnb * 32 + lr32]; }
    auto lora_issue = [&](int c) { const int pos = scan_pos(d, c * SC_CH + lr32); const bf16_t* src = LAp + (size_t)(b * TPB + pos) * 256 + lkind * 64 + lhi * 8;
#pragma unroll
      for (int kk = 0; kk < 4; ++kk) lA[kk] = *(const bf16x8*)(src + kk * 16); };
    auto lora_compute = [&](int c) { f32x16 acc = {};
#pragma unroll
      for (int kk = 0; kk < 4; ++kk) acc = __builtin_amdgcn_mfma_f32_32x32x16_bf16(lA[kk], lB[kk], acc, 0, 0, 0);
      float* dst = eic + (c & 1) * 4096 + lkind * 2048 + lnb * 32 + lr32; const float scl = lkind ? 1.f : 0.6065306597126334f;
#pragma unroll
      for (int r = 0; r < 16; ++r) { const int step = (r & 3) + 8 * (r >> 2) + 4 * lhi; dst[step * 64] = scl * sigmoidf_(acc[r] + lbias); } };
    auto issue_loads = [&](int c) { const int pos = scan_pos(d, c * SC_CH + ls); const size_t g = (size_t)(b * TPB + pos); const size_t off = g * 512 + h * 64 + j8;
      g_hp = (pos != 0 && pos != CL); g_hn = (pos != CL - 1 && pos != TPB - 1);
      const bf16_t* cur = RW + g * 1664 + h * 64 + j8;
#pragma unroll
      for (int q = 0; q < 3; ++q) { g_c[q] = *(const u32x4*)(cur + q * 512); g_p[q] = *(const u32x4*)((g_hp ? cur - 1664 : cur) + q * 512); g_n[q] = *(const u32x4*)((g_hn ? cur + 1664 : cur) + q * 512); }
      (void)off; };
    auto write_chunk = [&](int c) {
      float r[8], k[8], v[8], a[8], e[8], ic[8], w[8], bv[8], kd[8], mu_[3][8];
#pragma unroll
      for (int q = 0; q < 3; ++q) ld8f(p.in[9] + q * 512 + h * 64 + j8, mu_[q]);
      ld8f(p.in[11] + h * 64 + j8, ka); ld8f(p.in[16] + h * 64 + j8, rkv); ld8f(p.in[10] + h * 64 + j8, kkw);
#pragma unroll
      for (int q = 0; q < 3; ++q) { float cc[8], pp[8], nn[8]; unpack8(g_c[q], cc); unpack8(g_p[q], pp); unpack8(g_n[q], nn);
#pragma unroll
        for (int i = 0; i < 8; ++i) { const float pvv = g_hp ? pp[i] : 0.f, nxv = g_hn ? nn[i] : 0.f; const float o = cc[i] + mu_[q][i] * (0.5f * (pvv + nxv) - cc[i]);
          if (q == 0) r[i] = o; else if (q == 1) k[i] = o; else v[i] = o; } }
      { float ss = 0.f;
#pragma unroll
        for (int i = 0; i < 8; ++i) { a[i] = k[i] * kkw[i]; ss += a[i] * a[i]; }
        ss = red8(ss); const float inv = -1.f / fmaxf(sqrtf(ss), 1e-12f);
#pragma unroll
        for (int i = 0; i < 8; ++i) a[i] *= inv; }
      ld8f(eic + (c & 1) * 4096 + ls * 64 + j8, e); ld8f(eic + (c & 1) * 4096 + 2048 + ls * 64 + j8, ic);
#pragma unroll
      for (int i = 0; i < 8; ++i) { w[i] = __builtin_amdgcn_exp2f(-1.4426950408889634f * e[i]); bv[i] = -a[i] * ic[i]; kd[i] = k[i] * (1.f + (ic[i] - 1.f) * ka[i]); }
      { float t = 0.f;
#pragma unroll
        for (int i = 0; i < 8; ++i) t += r[i] * kd[i] * rkv[i];
        t = red8(t);
        if (rh == 0 && (tl & 7) == 0) TS[(size_t)(b * TPB + scan_pos(d, c * SC_CH + ls)) * 8 + h] = t; }
      float* o = (float*)(ldsg + (c & 1) * SC_BUF) + ls * SC_STEP + j8;
      *(f32x4*)(o) = (f32x4){a[0], a[1], a[2], a[3]}; *(f32x4*)(o + 4) = (f32x4){a[4], a[5], a[6], a[7]};
      *(f32x4*)(o + 64) = (f32x4){w[0], w[1], w[2], w[3]}; *(f32x4*)(o + 68) = (f32x4){w[4], w[5], w[6], w[7]};
      *(f32x4*)(o + 128) = (f32x4){bv[0], bv[1], bv[2], bv[3]}; *(f32x4*)(o + 132) = (f32x4){bv[4], bv[5], bv[6], bv[7]};
      *(f32x4*)(o + 192) = (f32x4){kd[0], kd[1], kd[2], kd[3]}; *(f32x4*)(o + 196) = (f32x4){kd[4], kd[5], kd[6], kd[7]};
      *(f32x4*)(o + 256) = (f32x4){r[0], r[1], r[2], r[3]}; *(f32x4*)(o + 260) = (f32x4){r[4], r[5], r[6], r[7]};
      if ((j8 >> 5) == rh) { float* ov = (float*)(ldsg + (c & 1) * SC_BUF) + ls * SC_STEP + 320 + (j8 & 31);
        *(f32x4*)(ov) = (f32x4){v[0], v[1], v[2], v[3]}; *(f32x4*)(ov + 4) = (f32x4){v[4], v[5], v[6], v[7]}; } };
    auto flush_y = [&](int c) { const int pos = scan_pos(d, c * SC_CH + ls), r4 = (tl & 7) * 4; const _Float16* yp = ypart + (c & 1) * 8192 + (ls * 32 + r4) * 8; h16x4 o;
#pragma unroll
      for (int q = 0; q < 4; ++q) { const h16x8 u = *(const h16x8*)(yp + q * 8); o[q] = (_Float16)((((float)u[0] + (float)u[1]) + ((float)u[2] + (float)u[3])) + (((float)u[4] + (float)u[5]) + ((float)u[6] + (float)u[7]))); }
      *(h16x4*)(Y + (size_t)(b * TPB + pos) * 512 + h * 64 + rh * 32 + r4) = o; };
    const int rl = lane >> 3, jg = lane & 7; f32x2 S0 = {0.f, 0.f}, S1 = {0.f, 0.f}, S2 = {0.f, 0.f}, S3 = {0.f, 0.f};
    if (wid >= 4) { lora_issue(0); issue_loads(0); lora_compute(0); lora_issue(1); lora_compute(1); }
    __syncthreads();
    if (wid >= 4) write_chunk(0);
    __syncthreads();
    if (wid < 4) __builtin_amdgcn_s_setprio(3);
    for (int c = 0; c < SC_NCH; ++c) {
      if (wid >= 4) { if (c + 1 < SC_NCH) issue_loads(c + 1); if (c + 2 < SC_NCH) lora_issue(c + 2); if (c >= 1) flush_y(c - 1); if (c + 2 < SC_NCH) lora_compute(c + 2); if (c + 1 < SC_NCH) write_chunk(c + 1); }
      else { const float* ob = (const float*)(ldsg + (c & 1) * SC_BUF) + jg * 8; const float* vb = (const float*)(ldsg + (c & 1) * SC_BUF) + 320 + wid * 8 + rl;
        _Float16* yb = ypart + (c & 1) * 8192 + (wid * 8 + rl) * 8 + jg;
#define SC_LD(X, s) do { const float* o_ = ob + (s) * SC_STEP; X##a0 = *(const f32x4*)(o_); X##a1 = *(const f32x4*)(o_ + 4); X##w0 = *(const f32x4*)(o_ + 64); X##w1 = *(const f32x4*)(o_ + 68); \
          X##b0 = *(const f32x4*)(o_ + 128); X##b1 = *(const f32x4*)(o_ + 132); X##k0 = *(const f32x4*)(o_ + 192); X##k1 = *(const f32x4*)(o_ + 196); \
          X##r0 = *(const f32x4*)(o_ + 256); X##r1 = *(const f32x4*)(o_ + 260); X##v = vb[(s) * SC_STEP]; } while (0)
#define LO2(x) __builtin_shufflevector(x, x, 0, 1)
#define HI2(x) __builtin_shufflevector(x, x, 2, 3)
#define SC_STEPF(X, sidx) do {   \
          f32x2 dA_ = S0 * LO2(X##a0), dB_ = S2 * LO2(X##a1); dA_ = S1 * HI2(X##a0) + dA_; dB_ = S3 * HI2(X##a1) + dB_; const f32x2 d_ = dA_ + dB_; \
          const f32x2 v2_ = {X##v, X##v}; \
          const f32x2 q0_ = S0 * LO2(X##w0) + v2_ * LO2(X##k0), q1_ = S1 * HI2(X##w0) + v2_ * HI2(X##k0), q2_ = S2 * LO2(X##w1) + v2_ * LO2(X##k1), q3_ = S3 * HI2(X##w1) + v2_ * HI2(X##k1); \
          const float sa_ = red8(d_.x + d_.y); const f32x2 sa2_ = {sa_, sa_}; \
          S0 = sa2_ * LO2(X##b0) + q0_; S1 = sa2_ * HI2(X##b0) + q1_; S2 = sa2_ * LO2(X##b1) + q2_; S3 = sa2_ * HI2(X##b1) + q3_; \
          f32x2 yA_ = S0 * LO2(X##r0), yB_ = S2 * LO2(X##r1); yA_ = S1 * HI2(X##r0) + yA_; yB_ = S3 * HI2(X##r1) + yB_; const f32x2 y_ = yA_ + yB_; \
          yb[(sidx) * 256] = (_Float16)(y_.x + y_.y); } while (0)
        f32x4 Aa0, Aa1, Aw0, Aw1, Ab0, Ab1, Ak0, Ak1, Ar0, Ar1, Ba0, Ba1, Bw0, Bw1, Bb0, Bb1, Bk0, Bk1, Br0, Br1; float Av, Bv;
        SC_LD(A, 0);
        for (int s8 = 0; s8 < SC_CH; s8 += 8) {
#pragma unroll
          for (int u = 0; u < 8; u += 2) { const int s = s8 + u;
            SC_LD(B, s + 1); SC_STEPF(A, s);
            SC_LD(A, (s + 2 < SC_CH ? s + 2 : SC_CH - 1)); SC_STEPF(B, s + 1); } }
#undef SC_LD
#undef SC_STEPF
      }
      __syncthreads();
    }
    __builtin_amdgcn_s_setprio(0);
    if (wid >= 4) flush_y(SC_NCH - 1);
    __syncthreads();
  }
}

__device__ __forceinline__ void even_out_phase(const Params& p) {
  const int tid_ = opaque_tid(), wid = tid_ >> 6, lane = tid_ & 63, gw = blockIdx.x * 8 + wid, nw = gridDim.x * 8, ch = lane * 8;
  const bf16_t* CUG = (const bf16_t*)(p.ws + OFF_CUG); const bf16_t* ZB = (const bf16_t*)(p.ws + OFF_ZB); bf16_t* MIX = (bf16_t*)(p.ws + OFF_MIX);
  const bf16_t* RW = (const bf16_t*)(p.ws + OFF_RW); const float* TS0 = (const float*)(p.ws + OFF_TS); const float* TS1 = TS0 + (size_t)MR * 8;
  const _Float16* Y0 = (const _Float16*)(p.ws + OFF_Y16); const _Float16* Y1 = Y0 + (size_t)MR * 512;
  float cw0[8], cw1[8], cw2[8], lw[8], lb[8], muv[8];
  ld8f(p.in[9] + 1024 + ch, muv); ld8f(p.in[8] + ch, cw0); ld8f(p.in[8] + 512 + ch, cw1); ld8f(p.in[8] + 1024 + ch, cw2); ld8f(p.in[17] + ch, lw); ld8f(p.in[18] + ch, lb);
  for (int g = gw; g < MR; g += nw) { const int pos = g % TPB; const bool hp = (pos != 0 && pos != CL), hn = (pos != CL - 1 && pos != TPB - 1);
    const bf16_t* cu = CUG + (size_t)g * 1024 + ch; float c[8], pv[8], nx[8], gg[8], o[8];
    ld8bf(cu, c); ld8bf(cu + 512, gg);
    if (hp) ld8bf(cu - 1024, pv); else {
#pragma unroll
      for (int i = 0; i < 8; ++i) pv[i] = 0.f; }
    if (hn) ld8bf(cu + 1024, nx); else {
#pragma unroll
      for (int i = 0; i < 8; ++i) nx[i] = 0.f; }
#pragma unroll
    for (int i = 0; i < 8; ++i) o[i] = gg[i] * (cw0[i] * pv[i] + cw1[i] * c[i] + cw2[i] * nx[i]);
    st8bf(MIX + (size_t)g * 1024 + ch, o);
    const size_t off = (size_t)g * 512 + ch; float y0[8], y1[8], v[8], zb[8];
    ld8h(Y0 + off, y0); ld8h(Y1 + off, y1); ld8bf(ZB + off, zb);
    { const bf16_t* vr = RW + (size_t)g * 1664 + 1024 + ch; float vc[8], vp[8], vn[8]; ld8bf(vr, vc); ld8bf(hp ? vr - 1664 : vr, vp); ld8bf(hn ? vr + 1664 : vr, vn);
#pragma unroll
      for (int i = 0; i < 8; ++i) { const float pvv = hp ? vp[i] : 0.f, nxv = hn ? vn[i] : 0.f; v[i] = vc[i] + muv[i] * (0.5f * (pvv + nxv) - vc[i]); } }
    const float t = TS0[(size_t)g * 8 + (lane >> 3)] + TS1[(size_t)g * 8 + (lane >> 3)];
    float s = 0.f;
#pragma unroll
    for (int i = 0; i < 8; ++i) { y0[i] += y1[i]; s += y0[i]; }
    s = red8(s); const float mean = s * (1.f / 64.f); float q = 0.f;
#pragma unroll
    for (int i = 0; i < 8; ++i) { y0[i] -= mean; q += y0[i] * y0[i]; }
    q = red8(q); const float rstd = rsqrtf(q * (1.f / 64.f) + 64e-5f);
#pragma unroll
    for (int i = 0; i < 8; ++i) o[i] = (y0[i] * rstd * lw[i] + lb[i] + t * v[i]) * zb[i];
    st8bf(MIX + (size_t)g * 1024 + 512 + ch, o); }
}

struct F6 { bf16_t* D0; const float* gate;
  __device__ __forceinline__ void operator()(int row, int pn, int c, f32x4 a0, f32x4 a1, f32x4 b0, f32x4 b1) const {
    const int b = row / TPB, pos = row - b * TPB, bb = pos < CL ? 8 : b; const float* gt = gate + bb * 3072 + 256 * pn + c; bf16_t* d = D0 + (size_t)row * 1024 + 256 * pn + c;
    st8(d, a0 * *(const f32x4*)gt, a1 * *(const f32x4*)(gt + 4)); st8(d + 128, b0 * *(const f32x4*)(gt + 128), b1 * *(const f32x4*)(gt + 132)); } };

struct F8 { bf16_t* P1S; bf16_t* Z;
  __device__ __forceinline__ void operator()(int row, int pn, int c, f32x4 a0, f32x4 a1, f32x4 b0, f32x4 b1) const {
    if (pn < 3) { bf16_t* d = P1S + (size_t)row * 768 + 256 * pn + c; st8(d, a0, a1); st8(d + 128, b0, b1); }
    else { bf16_t* d = Z + (size_t)row * 1024 + 256 * (pn - 3) + c; st8(d, silu4(a0), silu4(a1)); st8(d + 128, silu4(b0), silu4(b1)); } } };
struct FPlain { bf16_t* O; int ld;
  __device__ __forceinline__ void operator()(int row, int pn, int c, f32x4 a0, f32x4 a1, f32x4 b0, f32x4 b1) const { bf16_t* d = O + (size_t)row * ld + 256 * pn + c; st8(d, a0, a1); st8(d + 128, b0, b1); } };

struct EpiP9 { static constexpr bool PERM = true, AFTER_DRAIN = false; unsigned char* ws; const float* gkv; const float* gkr; PG8_LAS float* part;
  __device__ __forceinline__ void operator()(const f32x4 (&acc)[2][2][4][2], const pg8::Unit& u, int wr, int wc, int fr, int fq) const {
    bf16_t* const P1S = (bf16_t*)(ws + OFF_P1S); bf16_t* const Z = (bf16_t*)(ws + OFF_Z); bf16_t* const KVAN = (bf16_t*)(ws + OFF_KVAN); bf16_t* const KR = (bf16_t*)(ws + OFF_KROPE);
    const float* const rtab = (const float*)(ws + OFF_ROPE); float* const ssq = (float*)(ws + OFF_SSQ);
    int c = wc * 32 + 8 * fq; asm volatile("" : "+v"(c));
    const int pn = u.pn;
    if (pn >= 3) {
#pragma unroll
      for (int ai = 0; ai < 2; ++ai)
#pragma unroll
        for (int m = 0; m < 4; ++m) { const size_t row = (size_t)(u.pm * 256 + ai * 128 + wr * 64 + m * 16 + fr);
          { bf16_t* d = Z + row * 1024 + 256 * (pn - 3) + c; st8(d, silu4(acc[ai][0][m][0]), silu4(acc[ai][0][m][1])); st8(d + 128, silu4(acc[ai][1][m][0]), silu4(acc[ai][1][m][1])); } }
      return; }
#define SQ8(a_, b_) ((a_[0] * a_[0] + a_[1] * a_[1]) + (a_[2] * a_[2] + a_[3] * a_[3]) + ((b_[0] * b_[0] + b_[1] * b_[1]) + (b_[2] * b_[2] + b_[3] * b_[3])))
    if (pn <= 1) {
#pragma unroll
      for (int ai = 0; ai < 2; ++ai)
#pragma unroll
        for (int m = 0; m < 4; ++m) { const int rt = ai * 128 + wr * 64 + m * 16 + fr; const size_t row = (size_t)(u.pm * 256 + rt);
          float sq = SQ8(acc[ai][0][m][0], acc[ai][0][m][1]); st8(P1S + row * 384 + 256 * pn + c, acc[ai][0][m][0], acc[ai][0][m][1]);
          if (pn == 0) { sq += SQ8(acc[ai][1][m][0], acc[ai][1][m][1]); st8(P1S + row * 384 + 128 + c, acc[ai][1][m][0], acc[ai][1][m][1]); }
          sq += __shfl_xor(sq, 16); sq += __shfl_xor(sq, 32);
          if (fq == 0) part[1024 + rt * 4 + wc] = sq; asm volatile("" ::: "memory"); } }
    if (pn >= 1)
#pragma unroll
    for (int ai = 0; ai < 2; ++ai)
#pragma unroll
      for (int m = 0; m < 4; ++m) { const f32x4 y0 = acc[ai][1][m][0], y1 = acc[ai][1][m][1];
        float sq = (y0[0] * y0[0] + y0[1] * y0[1]) + (y0[2] * y0[2] + y0[3] * y0[3]) + ((y1[0] * y1[0] + y1[1] * y1[1]) + (y1[2] * y1[2] + y1[3] * y1[3]));
        if (pn == 2) { const f32x4 x0 = acc[ai][0][m][0], x1 = acc[ai][0][m][1];
          sq += (x0[0] * x0[0] + x0[1] * x0[1]) + (x0[2] * x0[2] + x0[3] * x0[3]) + ((x1[0] * x1[0] + x1[1] * x1[1]) + (x1[2] * x1[2] + x1[3] * x1[3])); }
        sq += __shfl_xor(sq, 16); sq += __shfl_xor(sq, 32);
        if (fq == 0) part[(ai * 128 + wr * 64 + m * 16 + fr) * 4 + wc] = sq; }
    asm volatile("s_waitcnt lgkmcnt(0)" ::: "memory"); __builtin_amdgcn_s_barrier(); asm volatile("" ::: "memory");
    if (pn <= 1 && wc == 0 && fq == 0) {
#pragma unroll
      for (int ai = 0; ai < 2; ++ai)
#pragma unroll
        for (int m = 0; m < 4; ++m) { const int rt = ai * 128 + wr * 64 + m * 16 + fr; const f32x4 pr = *(const PG8_LAS f32x4*)(part + 1024 + rt * 4);
          atomicAdd(ssq + (size_t)(u.pm * 256 + rt), (pr[0] + pr[1]) + (pr[2] + pr[3])); } }
    if (pn == 0) return;
    if (pn == 2) { const f32x4 g00 = *(const f32x4*)(gkv + c), g01 = *(const f32x4*)(gkv + c + 4), g10 = *(const f32x4*)(gkv + 128 + c), g11 = *(const f32x4*)(gkv + 128 + c + 4);
#pragma unroll
      for (int ai = 0; ai < 2; ++ai)
#pragma unroll
        for (int m = 0; m < 4; ++m) { const int rt = ai * 128 + wr * 64 + m * 16 + fr; const f32x4 pr = *(const PG8_LAS f32x4*)(part + rt * 4);
          const float rs = rsqrtf(((pr[0] + pr[1]) + (pr[2] + pr[3])) * (1.f / 256.f) + 1e-6f); bf16_t* d = KVAN + (size_t)(u.pm * 256 + rt) * 256 + c;
          st8(d, acc[ai][0][m][0] * rs * g00, acc[ai][0][m][1] * rs * g01); st8(d + 128, acc[ai][1][m][0] * rs * g10, acc[ai][1][m][1] * rs * g11); asm volatile("" ::: "memory"); } }
    else { const bool lat = (u.pm % 17) != 0;
      const f32x4 g0 = *(const f32x4*)(gkr + (c & 63)), g1 = *(const f32x4*)(gkr + (c & 63) + 4); const int half = fq >> 1, pb = 8 * (fq & 1);
#pragma unroll
      for (int ai = 0; ai < 2; ++ai)
#pragma unroll
        for (int m = 0; m < 4; ++m) { const int rt = ai * 128 + wr * 64 + m * 16 + fr; const size_t g = (size_t)(u.pm * 256 + rt);
          const f32x4 pr = *(const PG8_LAS f32x4*)(part + rt * 4); const float rs = rsqrtf(((pr[0] + pr[1]) + (pr[2] + pr[3])) * (1.f / 64.f) + 1e-6f);
          f32x4 x0 = acc[ai][1][m][0] * rs * g0, x1 = acc[ai][1][m][1] * rs * g1;
          if (lat) { const int t = (int)(g % TPB) - CL, idx = (wc & 1) ? (t & 63) : (t >> 6); const float* cs = rtab + (idx * 16 + pb) * 2;
            const float sg = half ? 1.f : -1.f;
            { const f32x4 c0 = *(const f32x4*)(cs), c1 = *(const f32x4*)(cs + 4); const f32x4 o0 = {__shfl_xor(x0[0], 32), __shfl_xor(x0[1], 32), __shfl_xor(x0[2], 32), __shfl_xor(x0[3], 32)};
              x0 = (f32x4){x0[0] * c0[0] + sg * o0[0] * c0[1], x0[1] * c0[2] + sg * o0[1] * c0[3], x0[2] * c1[0] + sg * o0[2] * c1[1], x0[3] * c1[2] + sg * o0[3] * c1[3]}; }
            { const f32x4 c2 = *(const f32x4*)(cs + 8), c3 = *(const f32x4*)(cs + 12); const f32x4 o1 = {__shfl_xor(x1[0], 32), __shfl_xor(x1[1], 32), __shfl_xor(x1[2], 32), __shfl_xor(x1[3], 32)};
              x1 = (f32x4){x1[0] * c2[0] + sg * o1[0] * c2[1], x1[1] * c2[2] + sg * o1[1] * c2[3], x1[2] * c3[0] + sg * o1[2] * c3[1], x1[3] * c3[2] + sg * o1[3] * c3[3]}; } }
          if (wc < 2) st8(KR + g * 64 + c, x0, x1); asm volatile("" ::: "memory"); } }
    asm volatile("" ::: "memory"); } };
struct EpiKV { static constexpr bool PERM = true, AFTER_DRAIN = false; bf16_t* O; const float* gk; PG8_LAS float* part;
  __device__ __forceinline__ void operator()(const f32x4 (&acc)[2][2][4][2], const pg8::Unit& u, int wr, int wc, int fr, int fq) const {
#pragma unroll
    for (int ai = 0; ai < 2; ++ai)
#pragma unroll
      for (int m = 0; m < 4; ++m) { const f32x4 x0 = acc[ai][0][m][0], x1 = acc[ai][0][m][1];
        float sq = (x0[0] * x0[0] + x0[1] * x0[1]) + (x0[2] * x0[2] + x0[3] * x0[3]) + ((x1[0] * x1[0] + x1[1] * x1[1]) + (x1[2] * x1[2] + x1[3] * x1[3]));
        sq += __shfl_xor(sq, 16); sq += __shfl_xor(sq, 32);
        if (fq == 0) part[(ai * 128 + wr * 64 + m * 16 + fr) * 4 + wc] = sq; }
    asm volatile("s_waitcnt lgkmcnt(0)" ::: "memory"); __builtin_amdgcn_s_barrier(); asm volatile("" ::: "memory");
    const int c = wc * 32 + 8 * fq; const f32x4 g0 = *(const f32x4*)(gk + c), g1 = *(const f32x4*)(gk + c + 4);
#pragma unroll
    for (int ai = 0; ai < 2; ++ai)
#pragma unroll
      for (int m = 0; m < 4; ++m) { const int rt = ai * 128 + wr * 64 + m * 16 + fr; const f32x4 pr = *(const PG8_LAS f32x4*)(part + rt * 4);
        const float rs = rsqrtf(((pr[0] + pr[1]) + (pr[2] + pr[3])) * (1.f / 128.f) + 1e-6f);
        bf16_t* d = O + (size_t)(u.pm * 256 + rt) * 2048 + 256 * u.pn + c;
        st8(d, acc[ai][0][m][0] * rs * g0, acc[ai][0][m][1] * rs * g1); st8(d + 128, acc[ai][1][m][0], acc[ai][1][m][1]); }
    asm volatile("" ::: "memory"); } };
__device__ __forceinline__ void rope8(float (&x)[8], int sub, int t, const float* tab) {
  const int axis = sub >> 2, half = (sub >> 1) & 1, p0 = (sub & 1) * 8; const int idx = axis ? (t & 63) : (t >> 6); float cs[16];
  ld8f(tab + (idx * 16 + p0) * 2, *(float(*)[8])&cs[0]); ld8f(tab + (idx * 16 + p0) * 2 + 8, *(float(*)[8])&cs[8]);
#pragma unroll
  for (int i = 0; i < 8; ++i) { const float other = __shfl_xor(x[i], 2); x[i] = half ? (x[i] * cs[2 * i] + other * cs[2 * i + 1]) : (x[i] * cs[2 * i] - other * cs[2 * i + 1]); }
}
__device__ __forceinline__ void lat_norm_phase(const Params& p) {
  const int tid_ = opaque_tid(), wid = tid_ >> 6, lane = tid_ & 63, gw = blockIdx.x * 8 + wid, nw = gridDim.x * 8;
  const bf16_t* P1S = (const bf16_t*)(p.ws + OFF_P1S); bf16_t* QAN = (bf16_t*)(p.ws + OFF_QAN);
  float w[8]; if (lane < 48) ld8f(p.in[21] + lane * 8, w);
  for (int g = gw; g < MR; g += nw) { if (g % TPB < CL) continue; float q[8]; float s1 = 0.f;
#pragma unroll
    for (int i = 0; i < 8; ++i) q[i] = 0.f;
    if (lane < 48) ld8bf(P1S + (size_t)g * 384 + lane * 8, q);
#pragma unroll
    for (int i = 0; i < 8; ++i) s1 += q[i] * q[i];
    s1 = wave_sum(s1); const float r1 = rsqrtf(s1 * (1.f / 384.f) + 1e-6f);
    if (lane < 48) {
#pragma unroll
      for (int i = 0; i < 8; ++i) q[i] *= r1 * w[i];
      st8bf(QAN + (size_t)g * 384 + lane * 8, q); } }
}
__device__ __forceinline__ void head_norm_phase(const Params& p) {
  const int tid_ = opaque_tid(), wid = tid_ >> 6, lane = tid_ & 63, gw = blockIdx.x * 8 + wid, nw = gridDim.x * 8, hd = lane >> 3, sub = lane & 7;
  bf16_t* KV = (bf16_t*)(p.ws + OFF_KVRAW);
  float gkn0[8], gkn1[8];
  ld8f(p.in[27] + sub * 16, gkn0); ld8f(p.in[27] + sub * 16 + 8, gkn1);
  for (int g = gw; g < MR; g += nw) {
    bf16_t* kp = KV + (size_t)g * 2048 + hd * 256 + sub * 16; float a[8], b[8]; ld8bf(kp, a); ld8bf(kp + 8, b); float s = 0.f;
#pragma unroll
    for (int i = 0; i < 8; ++i) s += a[i] * a[i] + b[i] * b[i];
    s = red8(s); const float rs = rsqrtf(s * (1.f / 128.f) + 1e-6f);
#pragma unroll
    for (int i = 0; i < 8; ++i) { a[i] *= rs * gkn0[i]; b[i] *= rs * gkn1[i]; }
    st8bf(kp, a); st8bf(kp + 8, b); }
}
struct F13 { float* out; const float* x; const bf16_t* D0; const float* gate;
  __device__ __forceinline__ void operator()(int row, int pn, int c, f32x4 a0, f32x4 a1, f32x4 b0, f32x4 b1) const {
    const int b = row / TPB, pos = row - b * TPB; if (pos < CL) return;
    const size_t o = (size_t)(b * SEQ + pos - CL) * 1024 + 256 * pn + c; const float* gt = gate + b * 3072 + 256 * pn + c; const bf16_t* d = D0 + (size_t)row * 1024 + 256 * pn + c;
    float d0[8], d1[8]; ld8bf(d, d0); ld8bf(d + 128, d1);
    const f32x4 x0 = *(const f32x4*)(x + o), x1 = *(const f32x4*)(x + o + 4), x2 = *(const f32x4*)(x + o + 128), x3 = *(const f32x4*)(x + o + 132);
    *(f32x4*)(out + o) = x0 + (f32x4){d0[0], d0[1], d0[2], d0[3]} + a0 * *(const f32x4*)gt;
    *(f32x4*)(out + o + 4) = x1 + (f32x4){d0[4], d0[5], d0[6], d0[7]} + a1 * *(const f32x4*)(gt + 4);
    *(f32x4*)(out + o + 128) = x2 + (f32x4){d1[0], d1[1], d1[2], d1[3]} + b0 * *(const f32x4*)(gt + 128);
    *(f32x4*)(out + o + 132) = x3 + (f32x4){d1[4], d1[5], d1[6], d1[7]} + b1 * *(const f32x4*)(gt + 132); } };

namespace att {
constexpr int NW = 8, QBLK = 32, KVBLK = 64, LDQ = 1536, LDK = 2048, LDKR = 64, LDO = 1024;
constexpr int SHM_V = KVBLK * 128 * 2, SHM_K = KVBLK * 128 * 2, SHM_KR = KVBLK * 64 * 2;
constexpr float THR = 8.f;
#define KSWZ(row, colB) ((row) * 256 + ((colB) ^ (((row) & 7) << 4)))
#define KRSWZ(row, colB) ((row) * 128 + ((colB) ^ (((row) & 7) << 4)))
#define SBAR() __builtin_amdgcn_sched_barrier(0)
__device__ __forceinline__ int crow(int r, int hi) { return (r & 3) + 8 * (r >> 2) + 4 * hi; }
__device__ __forceinline__ unsigned cvtpkv(float lo, float hi) { unsigned r; asm("v_cvt_pk_bf16_f32 %0, %1, %2" : "=v"(r) : "v"(lo), "v"(hi)); return r; }
__device__ __forceinline__ void partialSM(f32x16& p0, f32x16& p1, float& m_reg, float& mn, float& alpha) {
  constexpr float C = 1.4426950408889634f;
  float pmax = p0[0];
#pragma unroll
  for (int r = 1; r < 16; ++r) pmax = fmaxf(pmax, p0[r]);
#pragma unroll
  for (int r = 0; r < 16; ++r) pmax = fmaxf(pmax, p1[r]);
  { auto rr = __builtin_amdgcn_permlane32_swap(__float_as_uint(pmax), __float_as_uint(pmax), false, false);
    pmax = fmaxf(__uint_as_float(rr[0]), __uint_as_float(rr[1])); }
  if (__builtin_expect(__all(pmax - m_reg <= THR), 1)) { mn = m_reg; alpha = 1.f; }
  else { mn = fmaxf(m_reg, pmax); alpha = __builtin_amdgcn_exp2f((m_reg - mn) * C); m_reg = mn; }
  const float mnC = -mn * C;
#pragma unroll
  for (int r = 0; r < 16; ++r) p0[r] = fmaf(p0[r], C, mnC);
#pragma unroll
  for (int r = 0; r < 16; ++r) p1[r] = fmaf(p1[r], C, mnC);
#pragma unroll
  for (int r = 0; r < 16; ++r) p0[r] = __builtin_amdgcn_exp2f(p0[r]);
}
__device__ __forceinline__ void finishSM(f32x16& p0, f32x16& p1, float alpha, float& l_reg, bf16x8& pa0, bf16x8& pa1, bf16x8& pa2, bf16x8& pa3) {
#pragma unroll
  for (int r = 0; r < 16; ++r) p1[r] = __builtin_amdgcn_exp2f(p1[r]);
  float ps = 0;
#pragma unroll
  for (int r = 0; r < 16; ++r) ps += p0[r];
#pragma unroll
  for (int r = 0; r < 16; ++r) ps += p1[r];
  { auto rr = __builtin_amdgcn_permlane32_swap(__float_as_uint(ps), __float_as_uint(ps), false, false);
    ps = __uint_as_float(rr[0]) + __uint_as_float(rr[1]); }
  l_reg = l_reg * alpha + ps;
#define PK4(P, BASE, OUT) do { unsigned a0 = cvtpkv(P[BASE + 0], P[BASE + 1]), a1 = cvtpkv(P[BASE + 2], P[BASE + 3]);   \
    unsigned b0 = cvtpkv(P[BASE + 4], P[BASE + 5]), b1 = cvtpkv(P[BASE + 6], P[BASE + 7]);                              \
    auto r0 = __builtin_amdgcn_permlane32_swap(a0, b0, false, false); auto r1 = __builtin_amdgcn_permlane32_swap(a1, b1, false, false); \
    u32x4 w = {r0[0], r1[0], r0[1], r1[1]}; OUT = *reinterpret_cast<bf16x8*>(&w); } while (0)
  PK4(p0, 0, pa0); PK4(p0, 8, pa1); PK4(p1, 0, pa2); PK4(p1, 8, pa3);
#undef PK4
}
__device__ __forceinline__ void qkt(f32x16& p0, f32x16& p1, const char* Ks, const char* KRs, const bf16x8* qr, int r32, int hi) {
  p0 = f32x16{}; p1 = f32x16{};
#pragma unroll
  for (int d0 = 0; d0 < 8; ++d0) { const int cb = (d0 * 16 + hi * 8) * 2;
    const bf16x8 b0 = *reinterpret_cast<const bf16x8*>(Ks + KSWZ(r32, cb));
    const bf16x8 b1 = *reinterpret_cast<const bf16x8*>(Ks + KSWZ(32 + r32, cb));
    p0 = __builtin_amdgcn_mfma_f32_32x32x16_bf16(b0, qr[d0], p0, 0, 0, 0);
    p1 = __builtin_amdgcn_mfma_f32_32x32x16_bf16(b1, qr[d0], p1, 0, 0, 0); }
#pragma unroll
  for (int d0 = 0; d0 < 4; ++d0) { const int cb = (d0 * 16 + hi * 8) * 2;
    const bf16x8 b0 = *reinterpret_cast<const bf16x8*>(KRs + KRSWZ(r32, cb));
    const bf16x8 b1 = *reinterpret_cast<const bf16x8*>(KRs + KRSWZ(32 + r32, cb));
    p0 = __builtin_amdgcn_mfma_f32_32x32x16_bf16(b0, qr[8 + d0], p0, 0, 0, 0);
    p1 = __builtin_amdgcn_mfma_f32_32x32x16_bf16(b1, qr[8 + d0], p1, 0, 0, 0); }
}
__device__ __forceinline__ int v_st(int k, int c) { const int kk = (k & ~0xC) | ((k & 4) << 1) | ((k & 8) >> 1); return ((kk >> 3) * 4 + (c >> 5)) * 512 + ((kk & 7) * 32 + (c & 31)) * 2; }
__device__ __forceinline__ int v_rd_base(int lane) { return ((lane & 3) << 3) | (((lane >> 2) & 3) << 6) | (((lane >> 4) & 1) << 5) | (((lane >> 5) & 1) << 8); }
constexpr int v_rd_off(int d0, int ks, int half) { return d0 * 512 + ks * 4096 + half * 2048; }
template <int OFF> __device__ __forceinline__ s16x4 tr_read(int vb) {
  s16x4 r; asm volatile("ds_read_b64_tr_b16 %0, %1 offset:%2" : "=&v"(r) : "v"(vb), "i"(OFF) : "memory"); return r;
}
#define PKV(L, H) (bf16x8){L[0], L[1], L[2], L[3], H[0], H[1], H[2], H[3]}
struct VFrag { s16x4 l0, h0, l1, h1, l2, h2, l3, h3; };
template <int D0> __device__ __forceinline__ void pv_read(VFrag& f, int vb) {
  f.l0 = tr_read<v_rd_off(D0, 0, 0)>(vb); f.h0 = tr_read<v_rd_off(D0, 0, 1)>(vb); f.l1 = tr_read<v_rd_off(D0, 1, 0)>(vb); f.h1 = tr_read<v_rd_off(D0, 1, 1)>(vb);
  f.l2 = tr_read<v_rd_off(D0, 2, 0)>(vb); f.h2 = tr_read<v_rd_off(D0, 2, 1)>(vb); f.l3 = tr_read<v_rd_off(D0, 3, 0)>(vb); f.h3 = tr_read<v_rd_off(D0, 3, 1)>(vb); }
__device__ __forceinline__ void pv_mma(f32x16& od, const VFrag& f, bf16x8 pa0, bf16x8 pa1, bf16x8 pa2, bf16x8 pa3) {
  od = __builtin_amdgcn_mfma_f32_32x32x16_bf16(pa0, PKV(f.l0, f.h0), od, 0, 0, 0);
  od = __builtin_amdgcn_mfma_f32_32x32x16_bf16(pa1, PKV(f.l1, f.h1), od, 0, 0, 0);
  od = __builtin_amdgcn_mfma_f32_32x32x16_bf16(pa2, PKV(f.l2, f.h2), od, 0, 0, 0);
  od = __builtin_amdgcn_mfma_f32_32x32x16_bf16(pa3, PKV(f.l3, f.h3), od, 0, 0, 0); }
__device__ __forceinline__ void pv_d0(f32x16* o, int vb, bf16x8 pa0, bf16x8 pa1, bf16x8 pa2, bf16x8 pa3) {
  VFrag fa;
  pv_read<0>(fa, vb); asm volatile("s_waitcnt lgkmcnt(0)" ::: "memory"); SBAR(); pv_mma(o[0], fa, pa0, pa1, pa2, pa3); SBAR();
  pv_read<1>(fa, vb); asm volatile("s_waitcnt lgkmcnt(0)" ::: "memory"); SBAR(); pv_mma(o[1], fa, pa0, pa1, pa2, pa3); SBAR();
  pv_read<2>(fa, vb); asm volatile("s_waitcnt lgkmcnt(0)" ::: "memory"); SBAR(); pv_mma(o[2], fa, pa0, pa1, pa2, pa3); SBAR();
  pv_read<3>(fa, vb); asm volatile("s_waitcnt lgkmcnt(0)" ::: "memory"); SBAR(); pv_mma(o[3], fa, pa0, pa1, pa2, pa3);
}
__device__ __forceinline__ void attn_unit(const bf16_t* __restrict__ Qb, const bf16_t* __restrict__ Kh, const bf16_t* __restrict__ KRh, const bf16_t* __restrict__ Vh,
                                          const bf16_t* __restrict__ Zb, bf16_t* __restrict__ Ob, int seq, char* lds,
                                          const float* __restrict__ gqn, const float* __restrict__ gqr, const float* __restrict__ rtab, int t0, const float* __restrict__ ssq) {
  const int tid = opaque_tid(), wid = tid >> 6, lane = tid & 63, r32 = lane & 31, hi = lane >> 5;
  char* V_lds = lds; char* K_lds = lds + 3 * SHM_V; char* KR_lds = lds + 3 * SHM_V + 3 * SHM_K;
  float* ws = (float*)(lds + 3 * SHM_V + 3 * SHM_K + 3 * SHM_KR) + wid * 64; float* li_l = ws; float* al_l = ws + 32;
  float m_reg = -1e30f, l_reg = 0; f32x16 o[4] = {}; bf16x8 qr[12];
  const bf16_t* Qw = Qb + (long)(wid * QBLK + r32) * LDQ + hi * 8;
#pragma unroll
  for (int d0 = 0; d0 < 12; ++d0) qr[d0] = *reinterpret_cast<const bf16x8*>(Qw + d0 * 16);
  {
    float ssn = 0.f, ssr = 0.f;
#pragma unroll
    for (int d0 = 0; d0 < 12; ++d0) { float f[8]; unpack8(*reinterpret_cast<const u32x4*>(&qr[d0]), f); float t_ = 0.f;
#pragma unroll
      for (int e = 0; e < 8; ++e) t_ += f[e] * f[e];
      if (d0 < 8) ssn += t_; else ssr += t_; }
    { auto rr = __builtin_amdgcn_permlane32_swap(__float_as_uint(ssn), __float_as_uint(ssn), false, false); ssn = __uint_as_float(rr[0]) + __uint_as_float(rr[1]); }
    { auto rr = __builtin_amdgcn_permlane32_swap(__float_as_uint(ssr), __float_as_uint(ssr), false, false); ssr = __uint_as_float(rr[0]) + __uint_as_float(rr[1]); }
    const float rq = rsqrtf(ssq[wid * QBLK + r32] * (1.f / 384.f) + 1e-6f);
    const float rsn = rq * rsqrtf(ssn * rq * rq * (1.f / 128.f) + 1e-6f) * SM_SCALE, rsr = rq * rsqrtf(ssr * rq * rq * (1.f / 64.f) + 1e-6f) * SM_SCALE;
#pragma unroll
    for (int d0 = 0; d0 < 8; ++d0) { float f[8], g[8]; unpack8(*reinterpret_cast<const u32x4*>(&qr[d0]), f); ld8f(gqn + d0 * 16 + hi * 8, g);
#pragma unroll
      for (int e = 0; e < 8; ++e) f[e] *= rsn * g[e];
      const u32x4 w = pack8(f); qr[d0] = *reinterpret_cast<const bf16x8*>(&w); }
    const int tq = t0 + wid * QBLK + r32;
#pragma unroll
    for (int ax = 0; ax < 2; ++ax) { float f1[8], f2[8], g1[8], g2[8], cs[16]; unpack8(*reinterpret_cast<const u32x4*>(&qr[8 + 2 * ax]), f1); unpack8(*reinterpret_cast<const u32x4*>(&qr[9 + 2 * ax]), f2);
      ld8f(gqr + ax * 32 + hi * 8, g1); ld8f(gqr + ax * 32 + 16 + hi * 8, g2);
      const int idx = ax ? (tq & 63) : (tq >> 6); ld8f(rtab + (idx * 16 + hi * 8) * 2, *(float(*)[8])&cs[0]); ld8f(rtab + (idx * 16 + hi * 8) * 2 + 8, *(float(*)[8])&cs[8]);
#pragma unroll
      for (int e = 0; e < 8; ++e) { const float a = f1[e] * rsr * g1[e], b = f2[e] * rsr * g2[e]; f1[e] = a * cs[2 * e] - b * cs[2 * e + 1]; f2[e] = b * cs[2 * e] + a * cs[2 * e + 1]; }
      const u32x4 w1 = pack8(f1), w2 = pack8(f2); qr[8 + 2 * ax] = *reinterpret_cast<const bf16x8*>(&w1); qr[9 + 2 * ax] = *reinterpret_cast<const bf16x8*>(&w2); } }
  const int vb0 = (int)(uintptr_t)V_lds + v_rd_base(lane);
  PG8_LAS unsigned char* l3 = (PG8_LAS unsigned char*)lds; const int wu = __builtin_amdgcn_readfirstlane(wid);
  int offK[2], offV[2], offKR;
#pragma unroll
  for (int i = 0; i < 2; ++i) { const int q = (wid * 2 + i) * 1024 + lane * 16; const int row = q >> 8, colB = (q & 255) ^ ((row & 7) << 4); offK[i] = row * LDK + (colB >> 1);
    const int sub = q >> 9, within = q & 511, kk = (sub >> 2) * 8 + (within >> 6), c = (sub & 3) * 32 + ((within & 63) >> 1), k = (kk & ~0xC) | ((kk & 4) << 1) | ((kk & 8) >> 1); offV[i] = k * LDK + c; }
  { const int q = wid * 1024 + lane * 16; const int row = q >> 7, colB = (q & 127) ^ ((row & 7) << 4); offKR = row * LDKR + (colB >> 1); }
#define SDMA(b, k0) do { _Pragma("unroll") for (int _i = 0; _i < 2; ++_i) { \
      __builtin_amdgcn_global_load_lds((const unsigned*)(Kh + (long)(k0) * LDK + offK[_i]), (PG8_LAS unsigned*)(l3 + 3 * SHM_V + (b) * SHM_K + (wu * 2 + _i) * 1024), 16, 0, 0); \
      __builtin_amdgcn_global_load_lds((const unsigned*)(Vh + (long)(k0) * LDK + offV[_i]), (PG8_LAS unsigned*)(l3 + (b) * SHM_V + (wu * 2 + _i) * 1024), 16, 0, 0); } \
    __builtin_amdgcn_global_load_lds((const unsigned*)(KRh + (long)(k0) * LDKR + offKR), (PG8_LAS unsigned*)(l3 + 3 * SHM_V + 3 * SHM_K + (b) * SHM_KR + wu * 1024), 16, 0, 0); } while (0)
#define SWAIT() asm volatile("s_waitcnt vmcnt(0)" ::: "memory")
#define RESC(a) do { if (__any((a) < 1.f)) { if (hi == 0) al_l[r32] = (a); asm volatile("s_waitcnt lgkmcnt(0)" ::: "memory"); \
    _Pragma("unroll") for (int d = 0; d < 4; ++d) _Pragma("unroll") for (int r = 0; r < 16; ++r) o[d][r] *= al_l[crow(r, hi)]; } } while (0)
  f32x16 pA0, pA1, pB0, pB1; float mnA, mnB, alA, alB; bf16x8 pa0, pa1, pa2, pa3; const int NT = seq / KVBLK;
  int s_prev = 0, s_cur = 1, s_nxt = 2;
#define SGB_QK() do { _Pragma("unroll") for (int i_ = 0; i_ < 24; ++i_) { __builtin_amdgcn_sched_group_barrier(0x008, 1, 0); __builtin_amdgcn_sched_group_barrier(0x100, 1, 0); __builtin_amdgcn_sched_group_barrier(0x002, 4, 0); } } while (0)
#define ABODY(PX0, PX1, mnX, alX, PY0, PY1, alY, jj, LAST) do { \
    SBAR(); qkt(PX0, PX1, K_lds + s_cur * SHM_K, KR_lds + s_cur * SHM_KR, qr, r32, hi); \
    finishSM(PY0, PY1, alY, l_reg, pa0, pa1, pa2, pa3); SGB_QK(); SBAR(); \
    pv_d0(o, vb0 + s_prev * SHM_V, pa0, pa1, pa2, pa3); partialSM(PX0, PX1, m_reg, mnX, alX); \
    SWAIT(); __syncthreads(); \
    RESC(alX); \
    if (!(LAST)) { if ((jj) + 2 < NT) SDMA(s_prev, ((jj) + 2) * KVBLK); \
      const int t_ = s_prev; s_prev = s_cur; s_cur = s_nxt; s_nxt = t_; } } while (0)
  SDMA(0, 0); SDMA(1, KVBLK); SWAIT(); __syncthreads();
  qkt(pA0, pA1, K_lds, KR_lds, qr, r32, hi); partialSM(pA0, pA1, m_reg, mnA, alA);
  SDMA(2, 2 * KVBLK);
  for (int j = 1; j + 1 < NT; j += 2) {
    ABODY(pB0, pB1, mnB, alB, pA0, pA1, alA, j, false);
    ABODY(pA0, pA1, mnA, alA, pB0, pB1, alB, j + 1, false);
  }
  ABODY(pB0, pB1, mnB, alB, pA0, pA1, alA, NT - 1, true);
  finishSM(pB0, pB1, alB, l_reg, pa0, pa1, pa2, pa3); SBAR();
  pv_d0(o, vb0 + s_cur * SHM_V, pa0, pa1, pa2, pa3);
  __syncthreads();
#undef ABODY
  if (hi == 0) li_l[r32] = l_reg; asm volatile("s_waitcnt lgkmcnt(0)" ::: "memory");
  { bf16_t* Ot = (bf16_t*)(lds + wid * 8192);
#pragma unroll
    for (int r = 0; r < 16; ++r) { const int orow = crow(r, hi); const float rl = __builtin_amdgcn_rcpf(li_l[orow]);
#pragma unroll
      for (int d0 = 0; d0 < 4; ++d0) Ot[orow * 128 + d0 * 32 + r32] = (bf16_t)(cvtpk(o[d0][r] * rl, 0.f) & 0xffffu); }
    asm volatile("s_waitcnt lgkmcnt(0)" ::: "memory");
    bf16_t* Ow = Ob + (long)(wid * QBLK) * LDO; const bf16_t* Zw = Zb + (long)(wid * QBLK) * LDO;
#pragma unroll
    for (int i = 0; i < 8; ++i) { const int chunk = i * 64 + lane, row = chunk >> 4, c8 = (chunk & 15) * 8; float ov[8], zv[8];
      ld8bf(Ot + row * 128 + c8, ov); ld8bf(Zw + (long)row * LDO + c8, zv);
#pragma unroll
      for (int e = 0; e < 8; ++e) ov[e] *= zv[e];
      st8bf(Ow + (long)row * LDO + c8, ov); } }
  __syncthreads();
#undef SDMA
#undef SWAIT
#undef RESC
}
}

__device__ __forceinline__ void attn_phase(const Params& p, char* lds) {
  const bf16_t* QR = (const bf16_t*)(p.ws + OFF_QRAW); const bf16_t* KV = (const bf16_t*)(p.ws + OFF_KVRAW); const bf16_t* KR = (const bf16_t*)(p.ws + OFF_KROPE);
  const bf16_t* Z = (const bf16_t*)(p.ws + OFF_Z); bf16_t* OG = (bf16_t*)(p.ws + OFF_OG);
  const int G = gridDim.x, bx = blockIdx.x, vcu = (G % 8 == 0) ? (bx % 8) * (G / 8) + bx / 8 : bx;
  for (int u = vcu; u < NB * 8 * 16; u += G) { const int qb = u & 15, h = (u >> 4) & 7, b = u >> 7; const size_t g0 = (size_t)b * TPB, gq = g0 + CL + qb * 256;
    att::attn_unit(QR + gq * 1536 + h * 192, KV + g0 * 2048 + h * 256, KR + g0 * 64, KV + g0 * 2048 + h * 256 + 128, Z + gq * 1024 + h * 128, OG + gq * 1024 + h * 128, TPB, lds,
                   p.in[25], p.in[26], (const float*)(p.ws + OFF_ROPE), qb * 256, (const float*)(p.ws + OFF_SSQ) + gq); }
}

#define XB_TMO      128
#define XB_XCNT(j)  (256  + 64 * (j))
#define XB_XSUB(j)  (1280 + 64 * (j))
#define XB_XGEN(j)  (2304 + 64 * (j))
#define XB_TOP      3328
#define XB_TOPGEN   3392
#define XCD_BAR_WORDS 3456
#define XB_SPIN_CAP (1u << 18)
#define LAS __attribute__((address_space(3)))

__device__ __forceinline__ unsigned xb_ld(unsigned* p)              { return __hip_atomic_load(p, __ATOMIC_RELAXED, __HIP_MEMORY_SCOPE_AGENT); }
__device__ __forceinline__ unsigned xb_add(unsigned* p, unsigned v) { return __hip_atomic_fetch_add(p, v, __ATOMIC_RELAXED, __HIP_MEMORY_SCOPE_AGENT); }
__device__ __forceinline__ unsigned xb_xcc_id() { return (unsigned)__builtin_amdgcn_s_getreg((3 << 11) | 20) & 0xFu; }
#define XB_SPIN(cond, bar) do { unsigned _sp = 0; while (cond) { __builtin_amdgcn_s_sleep(1); \
    if ((++_sp & 255u) == 0u) { if (xb_ld(&(bar)[XB_TMO])) break; if (_sp > XB_SPIN_CAP) { atomicAdd(&(bar)[XB_TMO], 1u); break; } } } } while (0)

struct XcdBarrier {
    unsigned* bar; unsigned x;
    volatile LAS unsigned* st;
};

__device__ __forceinline__ XcdBarrier xcd_barrier_post(unsigned* bar, volatile LAS unsigned* st) {
    XcdBarrier b; b.bar = bar; b.x = xb_xcc_id(); b.st = st;
    if (threadIdx.x == 0) (void)xb_add(&bar[XB_XCNT(b.x)], 1u);
    return b;
}
__device__ __forceinline__ void xcd_barrier_complete(unsigned* bar, unsigned x, unsigned& nloc, unsigned& nx) {
    const unsigned G = gridDim.x * gridDim.y * gridDim.z;
    unsigned sum, cnt, mine, sp = 0u;
    for (;;) {
        sum = 0u; cnt = 0u; mine = 0u;
#pragma unroll
        for (unsigned j = 0; j < 16; ++j) { const unsigned c = xb_ld(&bar[XB_XCNT(j)]); sum += c; cnt += (c > 0u) ? 1u : 0u; mine = (j == x) ? c : mine; }
        if (sum == G) break;
        __builtin_amdgcn_s_sleep(1);
        if ((++sp & 255u) == 0u) { if (xb_ld(&bar[XB_TMO])) break; if (sp > XB_SPIN_CAP) { atomicAdd(&bar[XB_TMO], 1u); break; } }
    }
    nloc = mine > 0u ? mine : 1u; nx = cnt > 0u ? cnt : 1u;
}

__device__ __forceinline__ void xcd_barrier(const XcdBarrier& b) {
    asm volatile("s_waitcnt vmcnt(0)" ::: "memory");
    __syncthreads();
    if (threadIdx.x == 0) {
        unsigned* bar = b.bar;
        __builtin_amdgcn_s_waitcnt(0);
        unsigned nloc = b.st[0], nx = b.st[1];
        if (nloc == 0u) { xcd_barrier_complete(bar, b.x, nloc, nx); b.st[0] = nloc; b.st[1] = nx; }
        const unsigned old = xb_add(&bar[XB_XSUB(b.x)], 1u);
        const unsigned gen = old / nloc;
        if (old + 1u == (gen + 1u) * nloc) {
            __builtin_amdgcn_fence(__ATOMIC_RELEASE, "agent");
            asm volatile("s_waitcnt vmcnt(0)" ::: "memory");
            const unsigned og = xb_add(&bar[XB_TOP], 1u);
            const unsigned tg = og / nx;
            if (og + 1u == (tg + 1u) * nx) xb_add(&bar[XB_TOPGEN], 1u);
            else XB_SPIN(xb_ld(&bar[XB_TOPGEN]) == tg, bar);
            __builtin_amdgcn_fence(__ATOMIC_ACQUIRE, "agent");
            xb_add(&bar[XB_XGEN(b.x)], 1u);
            asm volatile("s_waitcnt vmcnt(0)" ::: "memory");
        } else {
            XB_SPIN(xb_ld(&bar[XB_XGEN(b.x)]) == gen, bar);
            __builtin_amdgcn_fence(__ATOMIC_ACQUIRE, "agent");
            asm volatile("s_waitcnt vmcnt(0)" ::: "memory");
        }
    }
    __syncthreads();
}


constexpr int LDS_XB_OFF = 155648;
constexpr int LDS_BYTES = LDS_XB_OFF + 256;
#ifndef PHMASK
#define PHMASK 0xFFFF
#endif
#define PH(k) ((PHMASK >> (k)) & 1)
__global__ void __launch_bounds__(512, 2) fwd_megakernel(Params p) {
  extern __shared__ __attribute__((aligned(16))) unsigned char lds[];
  cg::grid_group grid = cg::this_grid();
  PG8_LAS unsigned char* l3 = (PG8_LAS unsigned char*)lds;
  const float* mod = (const float*)(p.ws + OFF_MOD);
  if (threadIdx.x < 4) ((volatile LAS unsigned*)(l3 + LDS_XB_OFF))[threadIdx.x] = 0u;
  __syncthreads();
  if (blockIdx.x == 0) { unsigned* bw = (unsigned*)(p.ws + OFF_BAR); for (int i = threadIdx.x; i < XCD_BAR_WORDS; i += 512) bw[i] = 0u; __threadfence(); }
  if (PH(0)) {
  p0_prologue(p, lds);
  }
  grid.sync();
  XcdBarrier xbar = xcd_barrier_post((unsigned*)(p.ws + OFF_BAR), (volatile LAS unsigned*)(l3 + LDS_XB_OFF));
  if (PH(1)) {
  modnorm_phase(p, 0);
  }
  xcd_barrier(xbar);
  if (PH(2)) {
  { F0 f{(bf16_t*)(p.ws + OFF_CUG), (bf16_t*)(p.ws + OFF_RW), (bf16_t*)(p.ws + OFF_ZB)};
    run_gemm(l3, (const bf16_t*)(p.ws + OFF_H), (const bf16_t*)(p.ws + OFF_W0T), MR, 4352, 1024, f); }
  }
  xcd_barrier(xbar);
  if (PH(3)) {
  rwkv_prep_phase(p);
  }
  xcd_barrier(xbar);
  if (PH(5)) {
  scan_phase(p, lds);
  }
  xcd_barrier(xbar);
  if (PH(6)) {
  even_out_phase(p);
  }
  xcd_barrier(xbar);
  if (PH(7)) {
  { F6 f{(bf16_t*)(p.ws + OFF_DELTA0), mod + 2048};
    run_gemm(l3, (const bf16_t*)(p.ws + OFF_MIX), (const bf16_t*)(p.ws + OFF_WOUT0T), MR, 1024, 1024, f); }
  }
  xcd_barrier(xbar);
  if (PH(8)) {
  modnorm_phase(p, 1);
  }
  xcd_barrier(xbar);
  if (PH(9)) {
  { pg8::Gemm g{(const bf16_t*)(p.ws + OFF_H1), (const bf16_t*)(p.ws + OFF_W1T), MR, 1792, 1024}; pg8::StaticOrder S; S.init(MR, 1792, (int)gridDim.x, (int)blockIdx.x);
    EpiP9 E{p.ws, p.in[22], p.in[28], (PG8_LAS float*)(l3 + 131072)};
    pg8::gemm_phase<EpiP9, pg8::StaticOrder, false>(l3, g, S, E, nullptr); }
  }
  xcd_barrier(xbar);
  if (PH(11)) {
  { FPlain f{(bf16_t*)(p.ws + OFF_QRAW), 1536};
    run_gemm_lat(l3, (const bf16_t*)(p.ws + OFF_P1S), (const bf16_t*)(p.ws + OFF_WQBT), 1536, 384, f); }
  { pg8::Gemm g{(const bf16_t*)(p.ws + OFF_KVAN), (const bf16_t*)(p.ws + OFF_WKVBT), MR, 2048, 256}; pg8::StaticOrder S; S.init(MR, 2048, (int)gridDim.x, (int)blockIdx.x);
    EpiKV E{(bf16_t*)(p.ws + OFF_KVRAW), p.in[27], (PG8_LAS float*)(l3 + 131072)};
    pg8::gemm_phase<EpiKV, pg8::StaticOrder, false>(l3, g, S, E, nullptr); }
  }
  xcd_barrier(xbar);
  if (PH(13)) {
  attn_phase(p, (char*)lds);
  }
  xcd_barrier(xbar);
  if (PH(14)) {
  { F13 f{p.out, p.in[0], (const bf16_t*)(p.ws + OFF_DELTA0), mod + 9 * 3072 + 2048};
    run_gemm_lat(l3, (const bf16_t*)(p.ws + OFF_OG), (const bf16_t*)(p.ws + OFF_WOT), 1024, 1024, f); }
  }
}

extern "C" void kernel_launch(void* const* d_in, const int* in_sizes, int n_in, void* d_out, int out_size, void* d_ws, size_t ws_size, hipStream_t stream) {
  static int grid_blocks = 0;
  if (grid_blocks == 0) {
    if (n_in != 30 || ws_size < WS_NEED || out_size != NB * SEQ * DM) { fprintf(stderr, "kernel_launch: unexpected shapes: n_in %d ws %zu (need %zu) out %d\n", n_in, ws_size, (size_t)WS_NEED, out_size); grid_blocks = -1; return; }
    int dev = 0, cus = 0, per_cu = 0;
    hipGetDevice(&dev); hipDeviceGetAttribute(&cus, hipDeviceAttributeMultiprocessorCount, dev);
    if (hipFuncSetAttribute((const void*)fwd_megakernel, hipFuncAttributeMaxDynamicSharedMemorySize, LDS_BYTES) != hipSuccess) { fprintf(stderr, "kernel_launch: hipFuncSetAttribute failed\n"); grid_blocks = -1; return; }
    hipOccupancyMaxActiveBlocksPerMultiprocessor(&per_cu, (const void*)fwd_megakernel, 512, LDS_BYTES);
    if (per_cu < 1) { fprintf(stderr, "kernel_launch: occupancy query says %d blocks/CU\n", per_cu); per_cu = 1; }
    grid_blocks = cus * 1;
    (void)hipGetLastError();
  }
  if (grid_blocks < 0) return;
  Params p{};
  for (int i = 0; i < 30; ++i) p.in[i] = (const float*)d_in[i];
  p.out = (float*)d_out; p.ws = (unsigned char*)d_ws;
  void* args[] = {&p};
  hipError_t e = hipLaunchCooperativeKernel((const void*)fwd_megakernel, dim3(grid_blocks), dim3(512), args, LDS_BYTES, stream);
  if (e != hipSuccess) fprintf(stderr, "cooperative launch failed: %s (grid %d)\n", hipGetErrorString(e), grid_blocks);
}
```

```cpp
#include <hip/hip_runtime.h>
#include <hip/hip_cooperative_groups.h>
#include <cstdio>
namespace cg = cooperative_groups;
__device__ __forceinline__ int opaque_tid() { int t = threadIdx.x; asm volatile("" : "+v"(t)); return t; }
namespace pg8 {
#define PG8_LAS __attribute__((address_space(3)))
typedef unsigned short bf16_t;
typedef short bf16x8 __attribute__((ext_vector_type(8)));
typedef float f32x4 __attribute__((ext_vector_type(4)));
typedef unsigned u32x4 __attribute__((ext_vector_type(4)));
constexpr int BM = 256, BK = 64, HALF = 128, HTB = HALF * BK * 2  , STAGE_BYTES = 8 * HTB, NXCD = 8, WGM = 8;

__host__ __device__ __forceinline__ int lds_byte(int r, int c) { const int st = (r >> 4) * 2 + (c >> 5), rr = r & 15, cc = c & 31, ob = rr * 64 + cc * 2; return st * 1024 + (ob ^ (((ob >> 9) & 1) << 5)); }
__host__ __device__ __forceinline__ void stage_rc(int b, int& R, int& C) { const int st = b / 1024, sb = b % 1024, swz = sb ^ (((sb >> 9) & 1) << 5); R = (st >> 1) * 16 + swz / 64; C = (st & 1) * 32 + (swz % 64) / 2; }
__host__ __device__ __forceinline__ int perm32(int rho) { const int n = rho >> 4, i = rho & 15; return 8 * (i >> 2) + 4 * n + (i & 3); }

struct Unit { int pm, pn; };
struct Gemm { const bf16_t* A; const bf16_t* Bt; int M, N, K; };

struct StaticOrder {
    int nM, nN, nwg, G, c;
    __host__ __device__ void init(int M, int N, int G_, int c_) { nM = M / BM; nN = N / BM; nwg = nM * nN; G = G_; c = c_; }
    __host__ __device__ bool next(int i, Unit& u) const {
        const long L = (long)i * G + c; if (L >= nwg) return false;
        int wgid = (int)L; { const int q = nwg / NXCD, r = nwg % NXCD, xcd = wgid % NXCD, off = wgid / NXCD; wgid = (xcd < r ? xcd * (q + 1) : r * (q + 1) + (xcd - r) * q) + off; }
        const int nig = WGM * nN, gid = wgid / nig, fm = gid * WGM, gsz = (nM - fm) < WGM ? (nM - fm) : WGM;
        u.pm = fm + ((wgid % nig) % gsz); u.pn = (wgid % nig) / gsz; return true;
    }
    __device__ __forceinline__ void a_ready(const Unit&) const {}
    __device__ __forceinline__ void done(const Unit&) const {}
};
struct CountedOrder : StaticOrder {
    const unsigned* ready; unsigned need; unsigned* tmo;
    __device__ __forceinline__ void a_ready(const Unit& u) const {
        if (threadIdx.x < 64) {
            const unsigned long long t0 = __builtin_amdgcn_s_memrealtime(); unsigned polls = 0;
            while ((unsigned)__builtin_amdgcn_readfirstlane(__hip_atomic_load(ready + 64 * u.pm, __ATOMIC_RELAXED, __HIP_MEMORY_SCOPE_AGENT)) < need) {
                if ((++polls & 255u) == 0u && __builtin_amdgcn_readfirstlane(__hip_atomic_load(tmo, __ATOMIC_RELAXED, __HIP_MEMORY_SCOPE_AGENT)) != 0u) break;
                if (__builtin_amdgcn_s_memrealtime() - t0 > 2000000ull) {
                    if (threadIdx.x == 0) { unsigned expect = 0u; __hip_atomic_compare_exchange_strong(tmo + 1, &expect, 0x600u | (unsigned)(u.pm & 0xff), __ATOMIC_RELAXED, __ATOMIC_RELAXED, __HIP_MEMORY_SCOPE_AGENT); __hip_atomic_store(tmo, 1u, __ATOMIC_RELAXED, __HIP_MEMORY_SCOPE_AGENT); }
                    break; }
                __builtin_amdgcn_s_sleep(2); }
            __builtin_amdgcn_fence(__ATOMIC_ACQUIRE, "agent");
            asm volatile("s_waitcnt vmcnt(0)" ::: "memory");
        }
#if !defined(BROKEN_HOOK_NO_BARRIER)
        asm volatile("" ::: "memory"); __builtin_amdgcn_s_barrier(); asm volatile("" ::: "memory");
#endif
    }
};

__device__ __forceinline__ unsigned cvt_pk_bf16(float lo, float hi) { unsigned r; asm volatile("v_cvt_pk_bf16_f32 %0, %1, %2" : "=v"(r) : "v"(lo), "v"(hi)); return r; }
typedef float f32x2 __attribute__((ext_vector_type(2)));
__device__ __forceinline__ f32x2 gelu_pk(f32x2 v) {
    const f32x2 av = __builtin_elementwise_abs(v), d = av * 0.2316418882f + 1.0f;
    f32x2 t; t.x = __builtin_amdgcn_rcpf(d.x); t.y = __builtin_amdgcn_rcpf(d.y);
    f32x2 q = t * 0.5307027145f + (-0.7265760135f); q = q * t + 0.7107068705f; q = q * t + (-0.142248368f); q = q * t + 0.127414796f; q = q * t;
    const f32x2 s = (v * v) * (-0.72134752044f);
    f32x2 e; e.x = __builtin_amdgcn_exp2f(s.x); e.y = __builtin_amdgcn_exp2f(s.y);
    const f32x2 m = v * (q * e), r = v - m;
    f32x2 o; o.x = v.x < 0.f ? m.x : r.x; o.y = v.y < 0.f ? m.y : r.y; return o;
}

struct EpiF32 {
    static constexpr bool PERM = false, AFTER_DRAIN = false;
    float* C; int ldc; const float* bias;
    __device__ __forceinline__ void operator()(const f32x4 (&acc)[2][2][4][2], const Unit& u, int wr, int wc, int fr, int fq) const {
        const int row0 = u.pm * BM + wr * 64 + fr, col0 = u.pn * BM + wc * 32 + 4 * fq;
        f32x4 bv[2][2];
#pragma unroll
        for (int bj = 0; bj < 2; ++bj)
#pragma unroll
            for (int n = 0; n < 2; ++n) bv[bj][n] = bias ? *(const f32x4*)(bias + col0 + bj * HALF + n * 16) : (f32x4){0.f, 0.f, 0.f, 0.f};
#pragma unroll
        for (int ai = 0; ai < 2; ++ai)
#pragma unroll
            for (int m = 0; m < 4; ++m) { float* rowp = C + (size_t)(row0 + ai * HALF + m * 16) * ldc + col0;
#pragma unroll
                for (int bj = 0; bj < 2; ++bj)
#pragma unroll
                    for (int n = 0; n < 2; ++n) *(f32x4*)(rowp + bj * HALF + n * 16) = acc[ai][bj][m][n] + bv[bj][n]; }
    }
};
template <int ACT  > struct EpiBf16 {
    static constexpr bool PERM = true, AFTER_DRAIN = false;
    bf16_t* O; int ldc; const float* bias; int split_cols; size_t split_stride;
    __device__ __forceinline__ void operator()(const f32x4 (&acc)[2][2][4][2], const Unit& u, int wr, int wc, int fr, int fq) const {
        const int row0 = u.pm * BM + wr * 64 + fr; int colt = u.pn * BM; bf16_t* base = O;
        if (split_cols) { const int t = colt / split_cols; base += (size_t)t * split_stride; colt -= t * split_cols; }
        const int col0 = colt + wc * 32 + 8 * fq, bcol0 = u.pn * BM + wc * 32 + 8 * fq;
        f32x4 bv[2][2];
#pragma unroll
        for (int bj = 0; bj < 2; ++bj)
#pragma unroll
            for (int n = 0; n < 2; ++n) bv[bj][n] = bias ? *(const f32x4*)(bias + bcol0 + bj * HALF + 4 * n) : (f32x4){0.f, 0.f, 0.f, 0.f};
#pragma unroll
        for (int ai = 0; ai < 2; ++ai)
#pragma unroll
            for (int m = 0; m < 4; ++m) { bf16_t* rowp = base + (size_t)(row0 + ai * HALF + m * 16) * ldc + col0;
#pragma unroll
                for (int bj = 0; bj < 2; ++bj) { f32x4 v0 = acc[ai][bj][m][0] + bv[bj][0], v1 = acc[ai][bj][m][1] + bv[bj][1];
                    if (ACT == 1) { f32x2 a = gelu_pk((f32x2){v0[0], v0[1]}), b = gelu_pk((f32x2){v0[2], v0[3]}), c = gelu_pk((f32x2){v1[0], v1[1]}), d = gelu_pk((f32x2){v1[2], v1[3]});
                        v0 = (f32x4){a.x, a.y, b.x, b.y}; v1 = (f32x4){c.x, c.y, d.x, d.y}; }
                    if (ACT == 2) {
#pragma unroll
                        for (int j = 0; j < 4; ++j) { v0[j] = 0.5f * v0[j] * (1.0f + erff(v0[j] * 0.70710678f)); v1[j] = 0.5f * v1[j] * (1.0f + erff(v1[j] * 0.70710678f)); } }
                    u32x4 w; w.x = cvt_pk_bf16(v0[0], v0[1]); w.y = cvt_pk_bf16(v0[2], v0[3]); w.z = cvt_pk_bf16(v1[0], v1[1]); w.w = cvt_pk_bf16(v1[2], v1[3]);
                    *(u32x4*)(rowp + bj * HALF) = w; } }
    }
};

template <class Epi, class Sched, bool STAMP = false>
__device__ __forceinline__ void gemm_phase(PG8_LAS unsigned char* lds, const Gemm g, const Sched& S, const Epi& E, unsigned long long* stamps) {
    const int tid = opaque_tid(), wid = __builtin_amdgcn_readfirstlane(tid >> 6), lane = tid & 63, wr = wid >> 2, wc = wid & 3, fr = lane & 15, fq = lane >> 4;
    const int K = g.K, nt = K / BK;
    int ts_lo = 0, ts_hi = 0, nts = 0; const unsigned long long rt_entry = STAMP ? (unsigned long long)wall_clock64() : 0ull;
#define PG8_STAMP() do { if (STAMP && wid == 0 && nts < 64) { const unsigned long long _c = (unsigned long long)clock64(); \
        ts_lo = (lane == nts) ? (int)(unsigned)_c : ts_lo; ts_hi = (lane == nts) ? (int)(unsigned)(_c >> 32) : ts_hi; ++nts; } } while (0)
    PG8_STAMP();
    unsigned voffA[2], voffB[2];
#pragma unroll
    for (int i = 0; i < 2; ++i) { int R, C; stage_rc(tid * 16 + i * 8192, R, C); const int Rb = Epi::PERM ? ((R & ~31) + perm32(R & 31)) : R;
        voffA[i] = (unsigned)(R * K + C) * 2u; voffB[i] = (unsigned)(Rb * K + C) * 2u; }
    const size_t kstep = (size_t)(BK * 2);
    const size_t hstep = (size_t)HALF * K * 2;
    const size_t tstep = 2 * hstep;
    const unsigned ldsw = (unsigned)wid * 1024u;
    const int aoff = lds_byte(wr * 64 + fr, fq * 8), boff = lds_byte(wc * 32 + fr, fq * 8);
#define PG8_SA(b, h) (((b) * 2 + (h)) * HTB)
#define PG8_SB(b, h) ((4 + (b) * 2 + (h)) * HTB)
#define PG8_STAGE(bufoff, gbase, voff) do { _Pragma("unroll") for (int _i = 0; _i < 2; ++_i) \
        __builtin_amdgcn_global_load_lds((const unsigned*)((const char*)(gbase) + (voff)[_i]), (PG8_LAS unsigned*)(lds + (bufoff) + ldsw + _i * 8192), 16, 0, 0); } while (0)
#define PG8_LDA(dst, b, h) do { _Pragma("unroll") for (int m = 0; m < 4; ++m) _Pragma("unroll") for (int k = 0; k < 2; ++k) dst[m][k] = *(const PG8_LAS bf16x8*)(lds + PG8_SA(b, h) + aoff + m * 2048 + k * 1024); } while (0)
#define PG8_LDB(dst, b, h) do { _Pragma("unroll") for (int n = 0; n < 2; ++n) _Pragma("unroll") for (int k = 0; k < 2; ++k) dst[n][k] = *(const PG8_LAS bf16x8*)(lds + PG8_SB(b, h) + boff + n * 2048 + k * 1024); } while (0)
#define PG8_MMA(ai, bj, At, Bt) do { __builtin_amdgcn_s_setprio(1); _Pragma("unroll") for (int m = 0; m < 4; ++m) _Pragma("unroll") for (int n = 0; n < 2; ++n) _Pragma("unroll") for (int k = 0; k < 2; ++k) \
        acc[ai][bj][m][n] = __builtin_amdgcn_mfma_f32_16x16x32_bf16(Bt[n][k], At[m][k], acc[ai][bj][m][n], 0, 0, 0); __builtin_amdgcn_s_setprio(0); } while (0)
#define PG8_WAIT_V(n) asm volatile("s_waitcnt vmcnt(" #n ")" ::: "memory")
#define PG8_WAIT_L(n) asm volatile("s_waitcnt lgkmcnt(" #n ")" ::: "memory")
#define PG8_BAR __builtin_amdgcn_s_barrier()
#define PG8_SCHED __builtin_amdgcn_sched_barrier(0)
    Unit cur, nxt; int ui = 0;
    if (!S.next(0, cur)) return;
    f32x4 acc[2][2][4][2];
#pragma unroll
    for (int a = 0; a < 2; ++a)
#pragma unroll
        for (int b = 0; b < 2; ++b)
#pragma unroll
            for (int m = 0; m < 4; ++m)
#pragma unroll
                for (int n = 0; n < 2; ++n) acc[a][b][m][n] = (f32x4){0.f, 0.f, 0.f, 0.f};
    bf16x8 At[4][2], B0[2][2], B1[2][2];
    const char* cA = (const char*)g.A + (size_t)cur.pm * tstep; const char* cB = (const char*)g.Bt + (size_t)cur.pn * tstep;
    S.a_ready(cur);
    PG8_STAGE(PG8_SB(0, 0), cB, voffB); PG8_STAGE(PG8_SA(0, 0), cA, voffA); PG8_STAGE(PG8_SB(0, 1), cB + hstep, voffB); PG8_STAGE(PG8_SA(0, 1), cA + hstep, voffA);
    if (wr == 1) PG8_BAR;
    PG8_WAIT_V(4); PG8_BAR;
    PG8_STAGE(PG8_SB(1, 0), cB + kstep, voffB); PG8_STAGE(PG8_SA(1, 0), cA + kstep, voffA); PG8_STAGE(PG8_SB(1, 1), cB + hstep + kstep, voffB);
    PG8_WAIT_V(6); PG8_BAR;
    PG8_STAMP();
    for (;;) {
        const bool has_next = S.next(ui + 1, nxt);
        const char* nA = has_next ? (const char*)g.A + (size_t)nxt.pm * tstep : cA; const char* nB = has_next ? (const char*)g.Bt + (size_t)nxt.pn * tstep : cB;
#pragma unroll 1
        for (int t = 0; t < nt; t += 2) {
            const bool last = (t == nt - 2);
            const char* a1 = cA + (size_t)(t + 1) * kstep;
            const char* a2 = last ? nA : cA + (size_t)(t + 2) * kstep; const char* b2 = last ? nB : cB + (size_t)(t + 2) * kstep;
            const char* a3 = a2 + kstep; const char* b3 = b2 + kstep;
            if (last && has_next) S.a_ready(nxt);
            PG8_LDB(B0, 0, 0); PG8_SCHED; PG8_LDA(At, 0, 0); PG8_STAGE(PG8_SA(1, 1), a1 + hstep, voffA);
            PG8_WAIT_L(8); PG8_BAR; PG8_WAIT_L(0); PG8_MMA(0, 0, At, B0); PG8_BAR; PG8_SCHED;
            PG8_LDB(B1, 0, 1); PG8_STAGE(PG8_SB(0, 0), b2, voffB);
            PG8_BAR; PG8_WAIT_L(0); PG8_MMA(0, 1, At, B1); PG8_BAR;
            PG8_LDA(At, 0, 1); PG8_STAGE(PG8_SA(0, 0), a2, voffA);
            PG8_BAR; PG8_WAIT_L(0); PG8_MMA(1, 0, At, B0); PG8_BAR; PG8_SCHED;
            PG8_STAGE(PG8_SB(0, 1), b2 + hstep, voffB);
            PG8_WAIT_V(6); PG8_BAR; PG8_MMA(1, 1, At, B1); PG8_BAR;
            PG8_LDB(B0, 1, 0); PG8_SCHED; PG8_LDA(At, 1, 0); PG8_STAGE(PG8_SA(0, 1), a2 + hstep, voffA);
            PG8_WAIT_L(8); PG8_BAR; PG8_WAIT_L(0); PG8_MMA(0, 0, At, B0); PG8_BAR; PG8_SCHED;
            PG8_LDB(B1, 1, 1); PG8_STAGE(PG8_SB(1, 0), b3, voffB);
            PG8_BAR; PG8_WAIT_L(0); PG8_MMA(0, 1, At, B1); PG8_BAR;
            PG8_LDA(At, 1, 1); PG8_STAGE(PG8_SA(1, 0), a3, voffA);
            PG8_BAR; PG8_WAIT_L(0); PG8_MMA(1, 0, At, B0); PG8_BAR; PG8_SCHED;
            PG8_STAGE(PG8_SB(1, 1), b3 + hstep, voffB);
            PG8_WAIT_V(6); PG8_BAR; PG8_MMA(1, 1, At, B1); PG8_BAR;
        }
        PG8_STAMP();
        if constexpr (!Epi::AFTER_DRAIN) { E(acc, cur, wr, wc, fr, fq); S.done(cur); }
        PG8_STAMP();
        if (!has_next) break;
#pragma unroll
        for (int a = 0; a < 2; ++a)
#pragma unroll
            for (int b = 0; b < 2; ++b)
#pragma unroll
                for (int m = 0; m < 4; ++m)
#pragma unroll
                    for (int n = 0; n < 2; ++n) acc[a][b][m][n] = (f32x4){0.f, 0.f, 0.f, 0.f};
        cur = nxt; cA = nA; cB = nB; ++ui;
    }
    PG8_WAIT_V(0);
    if (wr == 0) PG8_BAR;
    PG8_BAR;
    if constexpr (Epi::AFTER_DRAIN) { E.fused(acc, cur, wr, wc, fr, fq, lds, wid, lane); S.done(cur); }
    PG8_STAMP();
    if (STAMP && wid == 0) { stamps[lane] = lane < nts ? (((unsigned long long)(unsigned)ts_hi << 32) | (unsigned)ts_lo) : 0ull;
        if (lane == 62) stamps[62] = rt_entry; if (lane == 63) stamps[63] = (unsigned long long)wall_clock64(); }
#undef PG8_STAMP
#undef PG8_SA
#undef PG8_SB
#undef PG8_STAGE
#undef PG8_LDA
#undef PG8_LDB
#undef PG8_MMA
#undef PG8_WAIT_V
#undef PG8_WAIT_L
#undef PG8_BAR
#undef PG8_SCHED
}
}

typedef unsigned short bf16_t;
typedef short bf16x8 __attribute__((ext_vector_type(8)));
typedef short s16x4 __attribute__((ext_vector_type(4)));
typedef float f32x4 __attribute__((ext_vector_type(4)));
typedef float f32x16 __attribute__((ext_vector_type(16)));
typedef unsigned u32x4 __attribute__((ext_vector_type(4)));
typedef unsigned u32x2 __attribute__((ext_vector_type(2)));
typedef float f32x2 __attribute__((ext_vector_type(2)));
typedef _Float16 h16x8 __attribute__((ext_vector_type(8)));
typedef _Float16 h16x4 __attribute__((ext_vector_type(4)));

constexpr int NB = 8, SEQ = 4096, CL = 256, DM = 1024, TPB = 4352  , MR = NB * TPB  ;
constexpr float SM_SCALE = 0.07216878364870322f;

constexpr size_t OFF_W0T = 0, OFF_WLT = 8912896, OFF_WOUT0T = 9961472, OFF_W1T = 12058624, OFF_WQBT = 15728640, OFF_WKVBT = 16908288, OFF_WOT = 17956864,
                 OFF_MOD = 20054016, OFF_R1 = 20275200;
constexpr size_t SZ_M512_2 = (size_t)MR * 512 * 2  , SZ_M1024_2 = (size_t)MR * 1024 * 2  ;
constexpr size_t OFF_H = OFF_R1, OFF_E16 = OFF_R1  , OFF_MIX = OFF_R1 + SZ_M1024_2, OFF_DELTA0 = OFF_R1;
constexpr size_t OFF_R2 = OFF_R1 + (size_t)MR * 1024 * 4  , OFF_RW = OFF_R2  ;
constexpr size_t OFF_R3 = OFF_R2 + (size_t)MR * 1664 * 2, OFF_CUG = OFF_R3, OFF_ZB = OFF_R3 + SZ_M1024_2;
constexpr size_t OFF_R4 = OFF_R3 + SZ_M1024_2 + SZ_M512_2, OFF_IC16 = OFF_R4  ;
constexpr size_t OFF_R5 = OFF_R4 + SZ_M1024_2, OFF_Y16 = OFF_R5  , OFF_LA = OFF_R4  ;
constexpr size_t WS_NEED0 = OFF_R5 + SZ_M1024_2;
constexpr size_t OFF_H1 = OFF_R1 + SZ_M1024_2, OFF_QAN = OFF_H1, OFF_OG = OFF_H1;
constexpr size_t OFF_Z = OFF_R2, OFF_P1S = OFF_R2 + SZ_M1024_2  , OFF_QRAW = OFF_P1S + (size_t)MR * 384 * 2  , OFF_KVRAW = OFF_QRAW + (size_t)MR * 1536 * 2, OFF_KROPE = OFF_KVRAW + (size_t)MR * 2048 * 2;
constexpr size_t OFF_KVAN = OFF_KROPE + (size_t)MR * 64 * 2;
constexpr size_t OFF_SSQ = OFF_KVAN + (size_t)MR * 256 * 2;
constexpr size_t WS_NEED1 = OFF_SSQ + (size_t)MR * 4;
constexpr size_t OFF_BAR = WS_NEED0 > WS_NEED1 ? WS_NEED0 : WS_NEED1;
constexpr size_t BAR_BYTES = 16384;
constexpr size_t OFF_ROPE = OFF_BAR + BAR_BYTES;
constexpr size_t OFF_TS = OFF_ROPE + 8192;
constexpr size_t WS_NEED = OFF_TS + (size_t)2 * MR * 8 * 4;
static_assert(WS_NEED <= 536870912, "workspace2");
static_assert(WS_NEED <= 536870912, "workspace");
static_assert(OFF_R1 % 256 == 0 && OFF_R2 % 256 == 0 && OFF_R3 % 256 == 0, "align");

struct Params { const float* in[30]; float* out; unsigned char* ws; };

__device__ __forceinline__ unsigned cvtpk(float lo, float hi) { unsigned r; asm("v_cvt_pk_bf16_f32 %0, %1, %2" : "=v"(r) : "v"(lo), "v"(hi)); return r; }
__device__ __forceinline__ u32x4 pack8(const float (&v)[8]) { return (u32x4){cvtpk(v[0], v[1]), cvtpk(v[2], v[3]), cvtpk(v[4], v[5]), cvtpk(v[6], v[7])}; }
__device__ __forceinline__ void unpack8(u32x4 w, float (&v)[8]) {
  v[0] = __uint_as_float(w.x << 16); v[1] = __uint_as_float(w.x & 0xffff0000u); v[2] = __uint_as_float(w.y << 16); v[3] = __uint_as_float(w.y & 0xffff0000u);
  v[4] = __uint_as_float(w.z << 16); v[5] = __uint_as_float(w.z & 0xffff0000u); v[6] = __uint_as_float(w.w << 16); v[7] = __uint_as_float(w.w & 0xffff0000u); }
__device__ __forceinline__ void ld8bf(const bf16_t* p, float (&v)[8]) { unpack8(*(const u32x4*)p, v); }
__device__ __forceinline__ void st8bf(bf16_t* p, const float (&v)[8]) { *(u32x4*)p = pack8(v); }
__device__ __forceinline__ void ld8f(const float* p, float (&v)[8]) { const f32x4 a = *(const f32x4*)p, b = *(const f32x4*)(p + 4); v[0] = a[0]; v[1] = a[1]; v[2] = a[2]; v[3] = a[3]; v[4] = b[0]; v[5] = b[1]; v[6] = b[2]; v[7] = b[3]; }
__device__ __forceinline__ void ld8h(const _Float16* p, float (&v)[8]) { const h16x8 a = *(const h16x8*)p;
#pragma unroll
  for (int i = 0; i < 8; ++i) v[i] = (float)a[i]; }
__device__ __forceinline__ float sigmoidf_(float x) { return __builtin_amdgcn_rcpf(1.f + __expf(-x)); }
__device__ __forceinline__ float siluf_(float x) { return x * sigmoidf_(x); }
__device__ __forceinline__ f32x4 silu4(f32x4 x) { return (f32x4){siluf_(x[0]), siluf_(x[1]), siluf_(x[2]), siluf_(x[3])}; }
__device__ __forceinline__ void st8(bf16_t* d, f32x4 a, f32x4 b) { *(u32x4*)d = (u32x4){cvtpk(a[0], a[1]), cvtpk(a[2], a[3]), cvtpk(b[0], b[1]), cvtpk(b[2], b[3])}; }
template <int CTRL> __device__ __forceinline__ float dppmov(float v) { return __int_as_float(__builtin_amdgcn_update_dpp(0, __float_as_int(v), CTRL, 0xF, 0xF, true)); }
__device__ __forceinline__ float red8(float x) { x += dppmov<0xB1>(x); x += dppmov<0x4E>(x); x += dppmov<0x141>(x); return x; }
__device__ __forceinline__ float wave_sum(float x) {
#pragma unroll
  for (int o = 32; o >= 1; o >>= 1) x += __shfl_xor(x, o);
  return x; }

template <class F> struct EpiT { static constexpr bool PERM = true, AFTER_DRAIN = false; F f;
  __device__ __forceinline__ void operator()(const f32x4 (&acc)[2][2][4][2], const pg8::Unit& u, int wr, int wc, int fr, int fq) const {
    const int c = wc * 32 + 8 * fq;
#pragma unroll
    for (int ai = 0; ai < 2; ++ai)
#pragma unroll
      for (int m = 0; m < 4; ++m) { const int row = u.pm * 256 + ai * 128 + wr * 64 + m * 16 + fr;
        f(row, u.pn, c, acc[ai][0][m][0], acc[ai][0][m][1], acc[ai][1][m][0], acc[ai][1][m][1]); } } };

struct LatOrder : pg8::StaticOrder {
  __device__ bool next(int i, pg8::Unit& u) const { const bool ok = pg8::StaticOrder::next(i, u); u.pm = (u.pm >> 4) * 17 + 1 + (u.pm & 15); return ok; } };
template <class F> __device__ __forceinline__ void run_gemm_lat(PG8_LAS unsigned char* lds, const bf16_t* A, const bf16_t* Bt, int N_, int K_, const F& f) {
  pg8::Gemm g{A, Bt, MR, N_, K_}; LatOrder S; S.init(NB * SEQ, N_, (int)gridDim.x, (int)blockIdx.x);
  EpiT<F> E{f};
  pg8::gemm_phase<EpiT<F>, LatOrder, false>(lds, g, S, E, nullptr);
}
template <class F> __device__ __forceinline__ void run_gemm(PG8_LAS unsigned char* lds, const bf16_t* A, const bf16_t* Bt, int M_, int N_, int K_, const F& f) {
  pg8::Gemm g{A, Bt, M_, N_, K_}; pg8::StaticOrder S; S.init(M_, N_, (int)gridDim.x, (int)blockIdx.x);
  EpiT<F> E{f};
  pg8::gemm_phase<EpiT<F>, pg8::StaticOrder, false>(lds, g, S, E, nullptr);
}

template <class MapF> __device__ __forceinline__ void transpose_w(const float* __restrict__ W, int K, int N, bf16_t* __restrict__ Wt, int Nout, MapF map, int gtid, int gn) {
  const int total = Nout * (K / 8);
#pragma unroll 4
  for (int q = gtid; q < total; q += gn) { const int n = q % Nout, k8 = q / Nout; const int src = map(n); float v[8];
#pragma unroll
    for (int i = 0; i < 8; ++i) v[i] = src >= 0 ? W[(size_t)(k8 * 8 + i) * N + src] : 0.f;
    st8bf(Wt + (size_t)n * K + k8 * 8, v); }
}
__device__ __forceinline__ int wsrc_col(int id, int n) {
  if (id == 0) { const int pn = n >> 8, c = n & 255, half = c >> 7, ci = c & 127;
    if (pn < 4) return half ? 1024 + 128 * pn + ci : 128 * pn + ci;
    if (pn < 8) return half ? 1536 + 128 * (pn - 4) + ci : 512 + 128 * (pn - 4) + ci;
    if (pn < 14) return 2048 + 256 * (pn - 8) + c;
    if (pn == 14) return half ? 3712 + ci : 3584 + ci;
    if (pn == 15) return 3840 + c;
    return half ? -1 : 4096 + ci; }
  if (id == 2) return n < 384 ? n : (n < 448 ? 640 + (n - 384) : (n < 512 ? -1 : (n < 768 ? 384 + (n - 512) : n - 64)));
  return n; }
__device__ __forceinline__ void transpose_tile(const float* __restrict__ W, int K, int N, bf16_t* __restrict__ Wt, int id, int tile, bf16_t* T, int tid, const float* __restrict__ kgain = nullptr) {
  const int nkt = K >> 6, n0 = (tile / nkt) << 6, k0 = (tile % nkt) << 6, src0 = wsrc_col(id, n0);
  const int kr = tid >> 4, c4 = (tid & 15) * 4;
#pragma unroll
  for (int pz = 0; pz < 2; ++pz) { const int k = k0 + pz * 32 + kr; f32x4 v = {0.f, 0.f, 0.f, 0.f};
    if (src0 >= 0) v = *(const f32x4*)(W + (size_t)k * N + src0 + c4);
    if (kgain) v = v * kgain[k];
    const unsigned lo = cvtpk(v[0], v[1]), hi = cvtpk(v[2], v[3]);
    T[(c4 + 0) * 72 + pz * 32 + kr] = (bf16_t)(lo & 0xffffu); T[(c4 + 1) * 72 + pz * 32 + kr] = (bf16_t)(lo >> 16);
    T[(c4 + 2) * 72 + pz * 32 + kr] = (bf16_t)(hi & 0xffffu); T[(c4 + 3) * 72 + pz * 32 + kr] = (bf16_t)(hi >> 16); }
  __syncthreads();
  { const int n = tid >> 3, k8 = (tid & 7) * 8; *(u32x4*)(Wt + (size_t)(n0 + n) * K + k0 + k8) = *(const u32x4*)(T + n * 72 + k8); }
  __syncthreads();
}
__device__ __forceinline__ void p0_prologue(const Params& p, unsigned char* ldsg) {
  const int tid = opaque_tid(), wid = tid >> 6, lane = tid & 63;
  float* sc = (float*)ldsg; float* red = sc + 9 * 1024;
  float* mod = (float*)(p.ws + OFF_MOD);
  for (int it = blockIdx.x; it < 96; it += gridDim.x) {
    for (int i = tid; i < 9 * 1024; i += 512) { const int bb = i >> 10, k = i & 1023; const float c = bb < 8 ? p.in[1][bb * 1024 + k] : p.in[3][k]; sc[i] = siluf_(c); }
    __syncthreads();
    const int l = it / 48, n0 = (it % 48) * 64; const float* W = p.in[4] + (size_t)l * 1024 * 3072 + n0 + lane; const int k0 = wid * 128;
    float acc[9];
#pragma unroll
    for (int bb = 0; bb < 9; ++bb) acc[bb] = 0.f;
#pragma unroll 16
    for (int k = 0; k < 128; ++k) { const float w = W[(size_t)(k0 + k) * 3072];
#pragma unroll
      for (int bb = 0; bb < 9; ++bb) acc[bb] += sc[bb * 1024 + k0 + k] * w; }
#pragma unroll
    for (int bb = 0; bb < 9; ++bb) red[(wid * 9 + bb) * 64 + lane] = acc[bb];
    __syncthreads();
    for (int i = tid; i < 9 * 64; i += 512) { const int bb = i >> 6, ln = i & 63; float s = 0.f;
#pragma unroll
      for (int w = 0; w < 8; ++w) s += red[(w * 9 + bb) * 64 + ln];
      mod[(l * 9 + bb) * 3072 + n0 + ln] = s + p.in[5][l * 3072 + n0 + ln]; }
    __syncthreads();
  }
  const int gtid = blockIdx.x * 512 + tid, gn = gridDim.x * 512;
  { bf16_t* T = (bf16_t*)(ldsg + 65536);
    auto do_tile = [&](int t) {
      if (t < 1088) transpose_tile(p.in[7], 1024, 4224, (bf16_t*)(p.ws + OFF_W0T), 0, t, T, tid);
      else if (t < 1344) transpose_tile(p.in[19], 1024, 1024, (bf16_t*)(p.ws + OFF_WOUT0T), 1, t - 1088, T, tid);
      else if (t < 1792) transpose_tile(p.in[20], 1024, 1728, (bf16_t*)(p.ws + OFF_W1T), 2, t - 1344, T, tid);
      else if (t < 1936) transpose_tile(p.in[23], 384, 1536, (bf16_t*)(p.ws + OFF_WQBT), 3, t - 1792, T, tid, p.in[21]);
      else if (t < 2064) transpose_tile(p.in[24], 256, 2048, (bf16_t*)(p.ws + OFF_WKVBT), 4, t - 1936, T, tid);
      else transpose_tile(p.in[29], 1024, 1024, (bf16_t*)(p.ws + OFF_WOT), 5, t - 2064, T, tid); };
    const int w = blockIdx.x, G = gridDim.x;
    if (G >= 256) { if (w < 96) { for (int t = w; t < 2320; t += 576) do_tile(t); }
                    else if (w < 256) { for (int j = 0; j < 3; ++j) for (int t = 96 + (w - 96) + j * 160; t < 2320; t += 576) do_tile(t); } }
    else for (int t = w; t < 2320; t += G) do_tile(t); }
  { float* tab = (float*)(p.ws + OFF_ROPE);
    for (int i = gtid; i < 1024; i += gn) { const int idx = i >> 4, pr = i & 15; const float inv = exp2f(-(float)pr * (13.287712379549449f / 16.f)); float sn, cs; sincosf((float)idx * inv, &sn, &cs);
      tab[i * 2] = cs; tab[i * 2 + 1] = sn; } }
}

__device__ __forceinline__ const float* xin_row(const Params& p, int g) { const int b = g / TPB, pos = g - b * TPB;
  return pos < CL ? p.in[2] + (size_t)(b * CL + pos) * DM : p.in[0] + (size_t)(b * SEQ + pos - CL) * DM; }
__device__ __forceinline__ void modnorm_phase(const Params& p, int l) {
  const int tid_ = opaque_tid(), wid = tid_ >> 6, lane = tid_ & 63, gw = blockIdx.x * 8 + wid, nw = gridDim.x * 8;
  const float* mod = (const float*)(p.ws + OFF_MOD); const float* nwp = p.in[6] + l * 1024;
  bf16_t* H = (bf16_t*)(p.ws + (l ? OFF_H1 : OFF_H)); const bf16_t* D0 = (const bf16_t*)(p.ws + OFF_DELTA0);
  for (int g = gw; g < MR; g += nw) { const int b = g / TPB, pos = g - b * TPB, bb = pos < CL ? 8 : b; const float* src = xin_row(p, g);
    f32x4 v[4]; float ss = 0.f;
#pragma unroll
    for (int i = 0; i < 4; ++i) { v[i] = *(const f32x4*)(src + i * 256 + lane * 4);
      if (l) { const u32x2 d = *(const u32x2*)(D0 + (size_t)g * 1024 + i * 256 + lane * 4);
        v[i][0] += __uint_as_float(d.x << 16); v[i][1] += __uint_as_float(d.x & 0xffff0000u); v[i][2] += __uint_as_float(d.y << 16); v[i][3] += __uint_as_float(d.y & 0xffff0000u); }
      ss += v[i][0] * v[i][0] + v[i][1] * v[i][1] + v[i][2] * v[i][2] + v[i][3] * v[i][3]; }
    ss = wave_sum(ss); const float rstd = rsqrtf(ss * (1.f / 1024.f) + 1e-6f); const float* md = mod + (l * 9 + bb) * 3072;
    if (l && lane == 0) ((float*)(p.ws + OFF_SSQ))[g] = 0.f;
#pragma unroll
    for (int i = 0; i < 4; ++i) { const int col = i * 256 + lane * 4; const f32x4 w = *(const f32x4*)(nwp + col), sh = *(const f32x4*)(md + col), sl = *(const f32x4*)(md + 1024 + col);
      const f32x4 h = v[i] * rstd * w * (sl + 1.f) + sh; *(u32x2*)(H + (size_t)g * 1024 + col) = (u32x2){cvtpk(h[0], h[1]), cvtpk(h[2], h[3])}; } }
}

struct F0 { bf16_t* CUG; bf16_t* RW; bf16_t* ZB;
  __device__ __forceinline__ void operator()(int row, int pn, int c, f32x4 a0, f32x4 a1, f32x4 b0, f32x4 b1) const {
    if (pn < 4) st8(CUG + (size_t)row * 1024 + 128 * pn + c, a0 * b0, a1 * b1);
    else if (pn < 8) st8(CUG + (size_t)row * 1024 + 512 + 128 * (pn - 4) + c, a0 * silu4(b0), a1 * silu4(b1));
    else if (pn < 14) { bf16_t* d = RW + (size_t)row * 1664 + 256 * (pn - 8) + c; st8(d, a0, a1); st8(d + 128, b0, b1); }
    else if (pn == 14) { st8(RW + (size_t)row * 1664 + 1536 + c, a0, a1); st8(ZB + (size_t)row * 512 + c, silu4(b0), silu4(b1)); }
    else if (pn == 15) { st8(ZB + (size_t)row * 512 + 128 + c, silu4(a0), silu4(a1)); st8(ZB + (size_t)row * 512 + 256 + c, silu4(b0), silu4(b1)); }
    else st8(ZB + (size_t)row * 512 + 384 + c, silu4(a0), silu4(a1)); } };

__device__ __forceinline__ void rwkv_prep_phase(const Params& p) {
  const int tid_ = opaque_tid(), wid = tid_ >> 6, lane = tid_ & 63, gw = blockIdx.x * 8 + wid, nw = gridDim.x * 8, sub = lane & 15;
  const bf16_t* RW = (const bf16_t*)(p.ws + OFF_RW); bf16_t* LA = (bf16_t*)(p.ws + OFF_LA);
  float m[8]; ld8f(p.in[9] + 1536 + sub * 8, m);
  for (int g = gw * 4 + (lane >> 4); g < MR; g += nw * 4) { const int pos = g % TPB; const bool hp = (pos != 0 && pos != CL), hn = (pos != CL - 1 && pos != TPB - 1);
    const bf16_t* cur = RW + (size_t)g * 1664 + 1536 + sub * 8; float c[8], pv[8], nx[8], o[8], z[8];
    ld8bf(cur, c); ld8bf(hp ? cur - 1664 : cur, pv); ld8bf(hn ? cur + 1664 : cur, nx);
#pragma unroll
    for (int i = 0; i < 8; ++i) { const float pvv = hp ? pv[i] : 0.f, nxv = hn ? nx[i] : 0.f; o[i] = c[i] + m[i] * (0.5f * (pvv + nxv) - c[i]); if (sub < 8) o[i] = tanhf(o[i]); z[i] = 0.f; }
    st8bf(LA + (size_t)g * 256 + sub * 8, o); st8bf(LA + (size_t)g * 256 + 128 + sub * 8, z); }
}

struct FL { _Float16* E0; _Float16* E1; _Float16* I0; _Float16* I1; const float* w0; const float* a0;
  __device__ __forceinline__ void operator()(int row, int pn, int c, f32x4 x0, f32x4 x1, f32x4 y0, f32x4 y1) const {
    const int dir = pn >> 2, kind = (pn >> 1) & 1, cb = 256 * (pn & 1) + c; const float* bias = (kind ? a0 : w0) + dir * 512; const float scl = kind ? 1.f : 0.6065306597126334f;
    _Float16* dst = E0 + (size_t)kind * (size_t)(I0 - E0) + (size_t)dir * ((size_t)MR * 512) + (size_t)row * 512 + cb; float bs[8]; h16x8 o;
    ld8f(bias + cb, bs);
#pragma unroll
    for (int i = 0; i < 4; ++i) { o[i] = (_Float16)(scl * sigmoidf_(bs[i] + x0[i])); o[4 + i] = (_Float16)(scl * sigmoidf_(bs[4 + i] + x1[i])); }
    *(h16x8*)dst = o;
    ld8f(bias + cb + 128, bs);
#pragma unroll
    for (int i = 0; i < 4; ++i) { o[i] = (_Float16)(scl * sigmoidf_(bs[i] + y0[i])); o[4 + i] = (_Float16)(scl * sigmoidf_(bs[4 + i] + y1[i])); }
    *(h16x8*)(dst + 128) = o; asm volatile("" ::: "memory"); } };

constexpr int SC_CH = 32  , SC_STEP = 352  , SC_BUF = SC_CH * SC_STEP * 4  , SC_NCH = TPB / SC_CH  ;
__device__ __forceinline__ int scan_pos(int d, int sg) { return d == 0 ? sg : (sg < CL ? CL - 1 - sg : TPB + CL - 1 - sg); }
__device__ __forceinline__ void scan_phase(const Params& p, unsigned char* ldsg) {
  const int tid = opaque_tid(), wid = tid >> 6, lane = tid & 63;
  _Float16* ypart = (_Float16*)(ldsg + 2 * SC_BUF);
  float* eic = (float*)(ldsg + 2 * SC_BUF + 32768);
  const bf16_t* RW = (const bf16_t*)(p.ws + OFF_RW);
  for (int item = blockIdx.x; item < 256; item += gridDim.x) {
    const int chain = (item & 7) | ((item >> 4) << 3), rh = (item >> 3) & 1, b = chain >> 4, h = (chain >> 1) & 7, d = chain & 1;
    const _Float16* E = (const _Float16*)(p.ws + OFF_E16 + (size_t)d * SZ_M512_2); const _Float16* IC = (const _Float16*)(p.ws + OFF_IC16 + (size_t)d * SZ_M512_2);
    _Float16* Y = (_Float16*)(p.ws + OFF_Y16 + (size_t)d * SZ_M512_2);
    const int tl = tid - 256, ls = tl >> 3, j8 = (tl & 7) * 8; float ka[8];
    float rkv[8], kkw[8]; float* TS = (float*)(p.ws + OFF_TS) + (size_t)d * MR * 8;

    u32x4 g_c[3], g_p[3], g_n[3]; bool g_hp = false, g_hn = false;
    const int lkind = (wid >> 1) & 1, lnb = wid & 1, lr32 = lane & 31, lhi = lane >> 5; bf16x8 lB[4], lA[4]; float lbias = 0.f;
    const bf16_t* LAp = (const bf16_t*)(p.ws + OFF_LA);
    if (wid >= 4) { const float* W = (lkind ? p.in[15] : p.in[13]) + (size_t)d * 64 * 512 + h * 64 + lnb * 32 + lr32;
#pragma unroll
      for (int kk = 0; kk < 4; ++kk) { float f[8];
#pragma unroll
        for (int e2 = 0; e2 < 8; ++e2) f[e2] = W[(size_t)(kk * 16 + lhi * 8 + e2) * 512];
        const u32x4 pk = pack8(f); lB[kk] = *reinterpret_cast<const bf16x8*>(&pk); }
      lbias = (lkind ? p.in[14] : p.in[12])[d * 512 + h * 64 + lnb * 32 + lr32]; }
    auto lora_issue = [&](int c) { const int pos = scan_pos(d, c * SC_CH + lr32); const bf16_t* src = LAp + (size_t)(b * TPB + pos) * 256 + lkind * 64 + lhi * 8;
#pragma unroll
      for (int kk = 0; kk < 4; ++kk) lA[kk] = *(const bf16x8*)(src + kk * 16); };
    auto lora_compute = [&](int c) { f32x16 acc = {};
#pragma unroll
      for (int kk = 0; kk < 4; ++kk) acc = __builtin_amdgcn_mfma_f32_32x32x16_bf16(lA[kk], lB[kk], acc, 0, 0, 0);
      float* dst = eic + (c & 1) * 4096 + lkind * 2048 + lnb * 32 + lr32; const float scl = lkind ? 1.f : 0.6065306597126334f;
#pragma unroll
      for (int r = 0; r < 16; ++r) { const int step = (r & 3) + 8 * (r >> 2) + 4 * lhi; dst[step * 64] = scl * sigmoidf_(acc[r] + lbias); } };
    auto issue_loads = [&](int c) { const int pos = scan_pos(d, c * SC_CH + ls); const size_t g = (size_t)(b * TPB + pos); const size_t off = g * 512 + h * 64 + j8;
      g_hp = (pos != 0 && pos != CL); g_hn = (pos != CL - 1 && pos != TPB - 1);
      const bf16_t* cur = RW + g * 1664 + h * 64 + j8;
#pragma unroll
      for (int q = 0; q < 3; ++q) { g_c[q] = *(const u32x4*)(cur + q * 512); g_p[q] = *(const u32x4*)((g_hp ? cur - 1664 : cur) + q * 512); g_n[q] = *(const u32x4*)((g_hn ? cur + 1664 : cur) + q * 512); }
      (void)off; };
    auto write_chunk = [&](int c) {
      float r[8], k[8], v[8], a[8], e[8], ic[8], w[8], bv[8], kd[8], mu_[3][8];
#pragma unroll
      for (int q = 0; q < 3; ++q) ld8f(p.in[9] + q * 512 + h * 64 + j8, mu_[q]);
      ld8f(p.in[11] + h * 64 + j8, ka); ld8f(p.in[16] + h * 64 + j8, rkv); ld8f(p.in[10] + h * 64 + j8, kkw);
#pragma unroll
      for (int q = 0; q < 3; ++q) { float cc[8], pp[8], nn[8]; unpack8(g_c[q], cc); unpack8(g_p[q], pp); unpack8(g_n[q], nn);
#pragma unroll
        for (int i = 0; i < 8; ++i) { const float pvv = g_hp ? pp[i] : 0.f, nxv = g_hn ? nn[i] : 0.f; const float o = cc[i] + mu_[q][i] * (0.5f * (pvv + nxv) - cc[i]);
          if (q == 0) r[i] = o; else if (q == 1) k[i] = o; else v[i] = o; } }
      { float ss = 0.f;
#pragma unroll
        for (int i = 0; i < 8; ++i) { a[i] = k[i] * kkw[i]; ss += a[i] * a[i]; }
        ss = red8(ss); const float inv = -1.f / fmaxf(sqrtf(ss), 1e-12f);
#pragma unroll
        for (int i = 0; i < 8; ++i) a[i] *= inv; }
      ld8f(eic + (c & 1) * 4096 + ls * 64 + j8, e); ld8f(eic + (c & 1) * 4096 + 2048 + ls * 64 + j8, ic);
#pragma unroll
      for (int i = 0; i < 8; ++i) { w[i] = __builtin_amdgcn_exp2f(-1.4426950408889634f * e[i]); bv[i] = -a[i] * ic[i]; kd[i] = k[i] * (1.f + (ic[i] - 1.f) * ka[i]); }
      { float t = 0.f;
#pragma unroll
        for (int i = 0; i < 8; ++i) t += r[i] * kd[i] * rkv[i];
        t = red8(t);
        if (rh == 0 && (tl & 7) == 0) TS[(size_t)(b * TPB + scan_pos(d, c * SC_CH + ls)) * 8 + h] = t; }
      float* o = (float*)(ldsg + (c & 1) * SC_BUF) + ls * SC_STEP + j8;
      *(f32x4*)(o) = (f32x4){a[0], a[1], a[2], a[3]}; *(f32x4*)(o + 4) = (f32x4){a[4], a[5], a[6], a[7]};
      *(f32x4*)(o + 64) = (f32x4){w[0], w[1], w[2], w[3]}; *(f32x4*)(o + 68) = (f32x4){w[4], w[5], w[6], w[7]};
      *(f32x4*)(o + 128) = (f32x4){bv[0], bv[1], bv[2], bv[3]}; *(f32x4*)(o + 132) = (f32x4){bv[4], bv[5], bv[6], bv[7]};
      *(f32x4*)(o + 192) = (f32x4){kd[0], kd[1], kd[2], kd[3]}; *(f32x4*)(o + 196) = (f32x4){kd[4], kd[5], kd[6], kd[7]};
      *(f32x4*)(o + 256) = (f32x4){r[0], r[1], r[2], r[3]}; *(f32x4*)(o + 260) = (f32x4){r[4], r[5], r[6], r[7]};
      if ((j8 >> 5) == rh) { float* ov = (float*)(ldsg + (c & 1) * SC_BUF) + ls * SC_STEP + 320 + (j8 & 31);
        *(f32x4*)(ov) = (f32x4){v[0], v[1], v[2], v[3]}; *(f32x4*)(ov + 4) = (f32x4){v[4], v[5], v[6], v[7]}; } };
    auto flush_y = [&](int c) { const int pos = scan_pos(d, c * SC_CH + ls), r4 = (tl & 7) * 4; const _Float16* yp = ypart + (c & 1) * 8192 + (ls * 32 + r4) * 8; h16x4 o;
#pragma unroll
      for (int q = 0; q < 4; ++q) { const h16x8 u = *(const h16x8*)(yp + q * 8); o[q] = (_Float16)((((float)u[0] + (float)u[1]) + ((float)u[2] + (float)u[3])) + (((float)u[4] + (float)u[5]) + ((float)u[6] + (float)u[7]))); }
      *(h16x4*)(Y + (size_t)(b * TPB + pos) * 512 + h * 64 + rh * 32 + r4) = o; };
    const int rl = lane >> 3, jg = lane & 7; f32x2 S0 = {0.f, 0.f}, S1 = {0.f, 0.f}, S2 = {0.f, 0.f}, S3 = {0.f, 0.f};
    if (wid >= 4) { lora_issue(0); issue_loads(0); lora_compute(0); lora_issue(1); lora_compute(1); }
    __syncthreads();
    if (wid >= 4) write_chunk(0);
    __syncthreads();
    if (wid < 4) __builtin_amdgcn_s_setprio(3);
    for (int c = 0; c < SC_NCH; ++c) {
      if (wid >= 4) { if (c + 1 < SC_NCH) issue_loads(c + 1); if (c + 2 < SC_NCH) lora_issue(c + 2); if (c >= 1) flush_y(c - 1); if (c + 2 < SC_NCH) lora_compute(c + 2); if (c + 1 < SC_NCH) write_chunk(c + 1); }
      else { const float* ob = (const float*)(ldsg + (c & 1) * SC_BUF) + jg * 8; const float* vb = (const float*)(ldsg + (c & 1) * SC_BUF) + 320 + wid * 8 + rl;
        _Float16* yb = ypart + (c & 1) * 8192 + (wid * 8 + rl) * 8 + jg;
#define SC_LD(X, s) do { const float* o_ = ob + (s) * SC_STEP; X##a0 = *(const f32x4*)(o_); X##a1 = *(const f32x4*)(o_ + 4); X##w0 = *(const f32x4*)(o_ + 64); X##w1 = *(const f32x4*)(o_ + 68); \
          X##b0 = *(const f32x4*)(o_ + 128); X##b1 = *(const f32x4*)(o_ + 132); X##k0 = *(const f32x4*)(o_ + 192); X##k1 = *(const f32x4*)(o_ + 196); \
          X##r0 = *(const f32x4*)(o_ + 256); X##r1 = *(const f32x4*)(o_ + 260); X##v = vb[(s) * SC_STEP]; } while (0)
#define LO2(x) __builtin_shufflevector(x, x, 0, 1)
#define HI2(x) __builtin_shufflevector(x, x, 2, 3)
#define SC_STEPF(X, sidx) do {   \
          f32x2 dA_ = S0 * LO2(X##a0), dB_ = S2 * LO2(X##a1); dA_ = S1 * HI2(X##a0) + dA_; dB_ = S3 * HI2(X##a1) + dB_; const f32x2 d_ = dA_ + dB_; \
          const f32x2 v2_ = {X##v, X##v}; \
          const f32x2 q0_ = S0 * LO2(X##w0) + v2_ * LO2(X##k0), q1_ = S1 * HI2(X##w0) + v2_ * HI2(X##k0), q2_ = S2 * LO2(X##w1) + v2_ * LO2(X##k1), q3_ = S3 * HI2(X##w1) + v2_ * HI2(X##k1); \
          const float sa_ = red8(d_.x + d_.y); const f32x2 sa2_ = {sa_, sa_}; \
          S0 = sa2_ * LO2(X##b0) + q0_; S1 = sa2_ * HI2(X##b0) + q1_; S2 = sa2_ * LO2(X##b1) + q2_; S3 = sa2_ * HI2(X##b1) + q3_; \
          f32x2 yA_ = S0 * LO2(X##r0), yB_ = S2 * LO2(X##r1); yA_ = S1 * HI2(X##r0) + yA_; yB_ = S3 * HI2(X##r1) + yB_; const f32x2 y_ = yA_ + yB_; \
          yb[(sidx) * 256] = (_Float16)(y_.x + y_.y); } while (0)
        f32x4 Aa0, Aa1, Aw0, Aw1, Ab0, Ab1, Ak0, Ak1, Ar0, Ar1, Ba0, Ba1, Bw0, Bw1, Bb0, Bb1, Bk0, Bk1, Br0, Br1; float Av, Bv;
        SC_LD(A, 0);
        for (int s8 = 0; s8 < SC_CH; s8 += 8) {
#pragma unroll
          for (int u = 0; u < 8; u += 2) { const int s = s8 + u;
            SC_LD(B, s + 1); SC_STEPF(A, s);
            SC_LD(A, (s + 2 < SC_CH ? s + 2 : SC_CH - 1)); SC_STEPF(B, s + 1); } }
#undef SC_LD
#undef SC_STEPF
      }
      __syncthreads();
    }
    __builtin_amdgcn_s_setprio(0);
    if (wid >= 4) flush_y(SC_NCH - 1);
    __syncthreads();
  }
}

__device__ __forceinline__ void even_out_phase(const Params& p) {
  const int tid_ = opaque_tid(), wid = tid_ >> 6, lane = tid_ & 63, gw = blockIdx.x * 8 + wid, nw = gridDim.x * 8, ch = lane * 8;
  const bf16_t* CUG = (const bf16_t*)(p.ws + OFF_CUG); const bf16_t* ZB = (const bf16_t*)(p.ws + OFF_ZB); bf16_t* MIX = (bf16_t*)(p.ws + OFF_MIX);
  const bf16_t* RW = (const bf16_t*)(p.ws + OFF_RW); const float* TS0 = (const float*)(p.ws + OFF_TS); const float* TS1 = TS0 + (size_t)MR * 8;
  const _Float16* Y0 = (const _Float16*)(p.ws + OFF_Y16); const _Float16* Y1 = Y0 + (size_t)MR * 512;
  float cw0[8], cw1[8], cw2[8], lw[8], lb[8], muv[8];
  ld8f(p.in[9] + 1024 + ch, muv); ld8f(p.in[8] + ch, cw0); ld8f(p.in[8] + 512 + ch, cw1); ld8f(p.in[8] + 1024 + ch, cw2); ld8f(p.in[17] + ch, lw); ld8f(p.in[18] + ch, lb);
  for (int g = gw; g < MR; g += nw) { const int pos = g % TPB; const bool hp = (pos != 0 && pos != CL), hn = (pos != CL - 1 && pos != TPB - 1);
    const bf16_t* cu = CUG + (size_t)g * 1024 + ch; float c[8], pv[8], nx[8], gg[8], o[8];
    ld8bf(cu, c); ld8bf(cu + 512, gg);
    if (hp) ld8bf(cu - 1024, pv); else {
#pragma unroll
      for (int i = 0; i < 8; ++i) pv[i] = 0.f; }
    if (hn) ld8bf(cu + 1024, nx); else {
#pragma unroll
      for (int i = 0; i < 8; ++i) nx[i] = 0.f; }
#pragma unroll
    for (int i = 0; i < 8; ++i) o[i] = gg[i] * (cw0[i] * pv[i] + cw1[i] * c[i] + cw2[i] * nx[i]);
    st8bf(MIX + (size_t)g * 1024 + ch, o);
    const size_t off = (size_t)g * 512 + ch; float y0[8], y1[8], v[8], zb[8];
    ld8h(Y0 + off, y0); ld8h(Y1 + off, y1); ld8bf(ZB + off, zb);
    { const bf16_t* vr = RW + (size_t)g * 1664 + 1024 + ch; float vc[8], vp[8], vn[8]; ld8bf(vr, vc); ld8bf(hp ? vr - 1664 : vr, vp); ld8bf(hn ? vr + 1664 : vr, vn);
#pragma unroll
      for (int i = 0; i < 8; ++i) { const float pvv = hp ? vp[i] : 0.f, nxv = hn ? vn[i] : 0.f; v[i] = vc[i] + muv[i] * (0.5f * (pvv + nxv) - vc[i]); } }
    const float t = TS0[(size_t)g * 8 + (lane >> 3)] + TS1[(size_t)g * 8 + (lane >> 3)];
    float s = 0.f;
#pragma unroll
    for (int i = 0; i < 8; ++i) { y0[i] += y1[i]; s += y0[i]; }
    s = red8(s); const float mean = s * (1.f / 64.f); float q = 0.f;
#pragma unroll
    for (int i = 0; i < 8; ++i) { y0[i] -= mean; q += y0[i] * y0[i]; }
    q = red8(q); const float rstd = rsqrtf(q * (1.f / 64.f) + 64e-5f);
#pragma unroll
    for (int i = 0; i < 8; ++i) o[i] = (y0[i] * rstd * lw[i] + lb[i] + t * v[i]) * zb[i];
    st8bf(MIX + (size_t)g * 1024 + 512 + ch, o); }
}

struct F6 { bf16_t* D0; const float* gate;
  __device__ __forceinline__ void operator()(int row, int pn, int c, f32x4 a0, f32x4 a1, f32x4 b0, f32x4 b1) const {
    const int b = row / TPB, pos = row - b * TPB, bb = pos < CL ? 8 : b; const float* gt = gate + bb * 3072 + 256 * pn + c; bf16_t* d = D0 + (size_t)row * 1024 + 256 * pn + c;
    st8(d, a0 * *(const f32x4*)gt, a1 * *(const f32x4*)(gt + 4)); st8(d + 128, b0 * *(const f32x4*)(gt + 128), b1 * *(const f32x4*)(gt + 132)); } };

struct F8 { bf16_t* P1S; bf16_t* Z;
  __device__ __forceinline__ void operator()(int row, int pn, int c, f32x4 a0, f32x4 a1, f32x4 b0, f32x4 b1) const {
    if (pn < 3) { bf16_t* d = P1S + (size_t)row * 768 + 256 * pn + c; st8(d, a0, a1); st8(d + 128, b0, b1); }
    else { bf16_t* d = Z + (size_t)row * 1024 + 256 * (pn - 3) + c; st8(d, silu4(a0), silu4(a1)); st8(d + 128, silu4(b0), silu4(b1)); } } };
struct FPlain { bf16_t* O; int ld;
  __device__ __forceinline__ void operator()(int row, int pn, int c, f32x4 a0, f32x4 a1, f32x4 b0, f32x4 b1) const { bf16_t* d = O + (size_t)row * ld + 256 * pn + c; st8(d, a0, a1); st8(d + 128, b0, b1); } };

struct EpiP9 { static constexpr bool PERM = true, AFTER_DRAIN = false; unsigned char* ws; const float* gkv; const float* gkr; PG8_LAS float* part;
  __device__ __forceinline__ void operator()(const f32x4 (&acc)[2][2][4][2], const pg8::Unit& u, int wr, int wc, int fr, int fq) const {
    bf16_t* const P1S = (bf16_t*)(ws + OFF_P1S); bf16_t* const Z = (bf16_t*)(ws + OFF_Z); bf16_t* const KVAN = (bf16_t*)(ws + OFF_KVAN); bf16_t* const KR = (bf16_t*)(ws + OFF_KROPE);
    const float* const rtab = (const float*)(ws + OFF_ROPE); float* const ssq = (float*)(ws + OFF_SSQ);
    int c = wc * 32 + 8 * fq; asm volatile("" : "+v"(c));
    const int pn = u.pn;
    if (pn >= 3) {
#pragma unroll
      for (int ai = 0; ai < 2; ++ai)
#pragma unroll
        for (int m = 0; m < 4; ++m) { const size_t row = (size_t)(u.pm * 256 + ai * 128 + wr * 64 + m * 16 + fr);
          { bf16_t* d = Z + row * 1024 + 256 * (pn - 3) + c; st8(d, silu4(acc[ai][0][m][0]), silu4(acc[ai][0][m][1])); st8(d + 128, silu4(acc[ai][1][m][0]), silu4(acc[ai][1][m][1])); } }
      return; }
#define SQ8(a_, b_) ((a_[0] * a_[0] + a_[1] * a_[1]) + (a_[2] * a_[2] + a_[3] * a_[3]) + ((b_[0] * b_[0] + b_[1] * b_[1]) + (b_[2] * b_[2] + b_[3] * b_[3])))
    if (pn <= 1) {
#pragma unroll
      for (int ai = 0; ai < 2; ++ai)
#pragma unroll
        for (int m = 0; m < 4; ++m) { const int rt = ai * 128 + wr * 64 + m * 16 + fr; const size_t row = (size_t)(u.pm * 256 + rt);
          float sq = SQ8(acc[ai][0][m][0], acc[ai][0][m][1]); st8(P1S + row * 384 + 256 * pn + c, acc[ai][0][m][0], acc[ai][0][m][1]);
          if (pn == 0) { sq += SQ8(acc[ai][1][m][0], acc[ai][1][m][1]); st8(P1S + row * 384 + 128 + c, acc[ai][1][m][0], acc[ai][1][m][1]); }
          sq += __shfl_xor(sq, 16); sq += __shfl_xor(sq, 32);
          if (fq == 0) part[1024 + rt * 4 + wc] = sq; asm volatile("" ::: "memory"); } }
    if (pn >= 1)
#pragma unroll
    for (int ai = 0; ai < 2; ++ai)
#pragma unroll
      for (int m = 0; m < 4; ++m) { const f32x4 y0 = acc[ai][1][m][0], y1 = acc[ai][1][m][1];
        float sq = (y0[0] * y0[0] + y0[1] * y0[1]) + (y0[2] * y0[2] + y0[3] * y0[3]) + ((y1[0] * y1[0] + y1[1] * y1[1]) + (y1[2] * y1[2] + y1[3] * y1[3]));
        if (pn == 2) { const f32x4 x0 = acc[ai][0][m][0], x1 = acc[ai][0][m][1];
          sq += (x0[0] * x0[0] + x0[1] * x0[1]) + (x0[2] * x0[2] + x0[3] * x0[3]) + ((x1[0] * x1[0] + x1[1] * x1[1]) + (x1[2] * x1[2] + x1[3] * x1[3])); }
        sq += __shfl_xor(sq, 16); sq += __shfl_xor(sq, 32);
        if (fq == 0) part[(ai * 128 + wr * 64 + m * 16 + fr) * 4 + wc] = sq; }
    asm volatile("s_waitcnt lgkmcnt(0)" ::: "memory"); __builtin_amdgcn_s_barrier(); asm volatile("" ::: "memory");
    if (pn <= 1 && wc == 0 && fq == 0) {
#pragma unroll
      for (int ai = 0; ai < 2; ++ai)
#pragma unroll
        for (int m = 0; m < 4; ++m) { const int rt = ai * 128 + wr * 64 + m * 16 + fr; const f32x4 pr = *(const PG8_LAS f32x4*)(part + 1024 + rt * 4);
          atomicAdd(ssq + (size_t)(u.pm * 256 + rt), (pr[0] + pr[1]) + (pr[2] + pr[3])); } }
    if (pn == 0) return;
    if (pn == 2) { const f32x4 g00 = *(const f32x4*)(gkv + c), g01 = *(const f32x4*)(gkv + c + 4), g10 = *(const f32x4*)(gkv + 128 + c), g11 = *(const f32x4*)(gkv + 128 + c + 4);
#pragma unroll
      for (int ai = 0; ai < 2; ++ai)
#pragma unroll
        for (int m = 0; m < 4; ++m) { const int rt = ai * 128 + wr * 64 + m * 16 + fr; const f32x4 pr = *(const PG8_LAS f32x4*)(part + rt * 4);
          const float rs = rsqrtf(((pr[0] + pr[1]) + (pr[2] + pr[3])) * (1.f / 256.f) + 1e-6f); bf16_t* d = KVAN + (size_t)(u.pm * 256 + rt) * 256 + c;
          st8(d, acc[ai][0][m][0] * rs * g00, acc[ai][0][m][1] * rs * g01); st8(d + 128, acc[ai][1][m][0] * rs * g10, acc[ai][1][m][1] * rs * g11); asm volatile("" ::: "memory"); } }
    else { const bool lat = (u.pm % 17) != 0;
      const f32x4 g0 = *(const f32x4*)(gkr + (c & 63)), g1 = *(const f32x4*)(gkr + (c & 63) + 4); const int half = fq >> 1, pb = 8 * (fq & 1);
#pragma unroll
      for (int ai = 0; ai < 2; ++ai)
#pragma unroll
        for (int m = 0; m < 4; ++m) { const int rt = ai * 128 + wr * 64 + m * 16 + fr; const size_t g = (size_t)(u.pm * 256 + rt);
          const f32x4 pr = *(const PG8_LAS f32x4*)(part + rt * 4); const float rs = rsqrtf(((pr[0] + pr[1]) + (pr[2] + pr[3])) * (1.f / 64.f) + 1e-6f);
          f32x4 x0 = acc[ai][1][m][0] * rs * g0, x1 = acc[ai][1][m][1] * rs * g1;
          if (lat) { const int t = (int)(g % TPB) - CL, idx = (wc & 1) ? (t & 63) : (t >> 6); const float* cs = rtab + (idx * 16 + pb) * 2;
            const float sg = half ? 1.f : -1.f;
            { const f32x4 c0 = *(const f32x4*)(cs), c1 = *(const f32x4*)(cs + 4); const f32x4 o0 = {__shfl_xor(x0[0], 32), __shfl_xor(x0[1], 32), __shfl_xor(x0[2], 32), __shfl_xor(x0[3], 32)};
              x0 = (f32x4){x0[0] * c0[0] + sg * o0[0] * c0[1], x0[1] * c0[2] + sg * o0[1] * c0[3], x0[2] * c1[0] + sg * o0[2] * c1[1], x0[3] * c1[2] + sg * o0[3] * c1[3]}; }
            { const f32x4 c2 = *(const f32x4*)(cs + 8), c3 = *(const f32x4*)(cs + 12); const f32x4 o1 = {__shfl_xor(x1[0], 32), __shfl_xor(x1[1], 32), __shfl_xor(x1[2], 32), __shfl_xor(x1[3], 32)};
              x1 = (f32x4){x1[0] * c2[0] + sg * o1[0] * c2[1], x1[1] * c2[2] + sg * o1[1] * c2[3], x1[2] * c3[0] + sg * o1[2] * c3[1], x1[3] * c3[2] + sg * o1[3] * c3[3]}; } }
          if (wc < 2) st8(KR + g * 64 + c, x0, x1); asm volatile("" ::: "memory"); } }
    asm volatile("" ::: "memory"); } };
struct EpiKV { static constexpr bool PERM = true, AFTER_DRAIN = false; bf16_t* O; const float* gk; PG8_LAS float* part;
  __device__ __forceinline__ void operator()(const f32x4 (&acc)[2][2][4][2], const pg8::Unit& u, int wr, int wc, int fr, int fq) const {
#pragma unroll
    for (int ai = 0; ai < 2; ++ai)
#pragma unroll
      for (int m = 0; m < 4; ++m) { const f32x4 x0 = acc[ai][0][m][0], x1 = acc[ai][0][m][1];
        float sq = (x0[0] * x0[0] + x0[1] * x0[1]) + (x0[2] * x0[2] + x0[3] * x0[3]) + ((x1[0] * x1[0] + x1[1] * x1[1]) + (x1[2] * x1[2] + x1[3] * x1[3]));
        sq += __shfl_xor(sq, 16); sq += __shfl_xor(sq, 32);
        if (fq == 0) part[(ai * 128 + wr * 64 + m * 16 + fr) * 4 + wc] = sq; }
    asm volatile("s_waitcnt lgkmcnt(0)" ::: "memory"); __builtin_amdgcn_s_barrier(); asm volatile("" ::: "memory");
    const int c = wc * 32 + 8 * fq; const f32x4 g0 = *(const f32x4*)(gk + c), g1 = *(const f32x4*)(gk + c + 4);
#pragma unroll
    for (int ai = 0; ai < 2; ++ai)
#pragma unroll
      for (int m = 0; m < 4; ++m) { const int rt = ai * 128 + wr * 64 + m * 16 + fr; const f32x4 pr = *(const PG8_LAS f32x4*)(part + rt * 4);
        const float rs = rsqrtf(((pr[0] + pr[1]) + (pr[2] + pr[3])) * (1.f / 128.f) + 1e-6f);
        bf16_t* d = O + (size_t)(u.pm * 256 + rt) * 2048 + 256 * u.pn + c;
        st8(d, acc[ai][0][m][0] * rs * g0, acc[ai][0][m][1] * rs * g1); st8(d + 128, acc[ai][1][m][0], acc[ai][1][m][1]); }
    asm volatile("" ::: "memory"); } };
__device__ __forceinline__ void rope8(float (&x)[8], int sub, int t, const float* tab) {
  const int axis = sub >> 2, half = (sub >> 1) & 1, p0 = (sub & 1) * 8; const int idx = axis ? (t & 63) : (t >> 6); float cs[16];
  ld8f(tab + (idx * 16 + p0) * 2, *(float(*)[8])&cs[0]); ld8f(tab + (idx * 16 + p0) * 2 + 8, *(float(*)[8])&cs[8]);
#pragma unroll
  for (int i = 0; i < 8; ++i) { const float other = __shfl_xor(x[i], 2); x[i] = half ? (x[i] * cs[2 * i] + other * cs[2 * i + 1]) : (x[i] * cs[2 * i] - other * cs[2 * i + 1]); }
}
__device__ __forceinline__ void lat_norm_phase(const Params& p) {
  const int tid_ = opaque_tid(), wid = tid_ >> 6, lane = tid_ & 63, gw = blockIdx.x * 8 + wid, nw = gridDim.x * 8;
  const bf16_t* P1S = (const bf16_t*)(p.ws + OFF_P1S); bf16_t* QAN = (bf16_t*)(p.ws + OFF_QAN);
  float w[8]; if (lane < 48) ld8f(p.in[21] + lane * 8, w);
  for (int g = gw; g < MR; g += nw) { if (g % TPB < CL) continue; float q[8]; float s1 = 0.f;
#pragma unroll
    for (int i = 0; i < 8; ++i) q[i] = 0.f;
    if (lane < 48) ld8bf(P1S + (size_t)g * 384 + lane * 8, q);
#pragma unroll
    for (int i = 0; i < 8; ++i) s1 += q[i] * q[i];
    s1 = wave_sum(s1); const float r1 = rsqrtf(s1 * (1.f / 384.f) + 1e-6f);
    if (lane < 48) {
#pragma unroll
      for (int i = 0; i < 8; ++i) q[i] *= r1 * w[i];
      st8bf(QAN + (size_t)g * 384 + lane * 8, q); } }
}
__device__ __forceinline__ void head_norm_phase(const Params& p) {
  const int tid_ = opaque_tid(), wid = tid_ >> 6, lane = tid_ & 63, gw = blockIdx.x * 8 + wid, nw = gridDim.x * 8, hd = lane >> 3, sub = lane & 7;
  bf16_t* KV = (bf16_t*)(p.ws + OFF_KVRAW);
  float gkn0[8], gkn1[8];
  ld8f(p.in[27] + sub * 16, gkn0); ld8f(p.in[27] + sub * 16 + 8, gkn1);
  for (int g = gw; g < MR; g += nw) {
    bf16_t* kp = KV + (size_t)g * 2048 + hd * 256 + sub * 16; float a[8], b[8]; ld8bf(kp, a); ld8bf(kp + 8, b); float s = 0.f;
#pragma unroll
    for (int i = 0; i < 8; ++i) s += a[i] * a[i] + b[i] * b[i];
    s = red8(s); const float rs = rsqrtf(s * (1.f / 128.f) + 1e-6f);
#pragma unroll
    for (int i = 0; i < 8; ++i) { a[i] *= rs * gkn0[i]; b[i] *= rs * gkn1[i]; }
    st8bf(kp, a); st8bf(kp + 8, b); }
}
struct F13 { float* out; const float* x; const bf16_t* D0; const float* gate;
  __device__ __forceinline__ void operator()(int row, int pn, int c, f32x4 a0, f32x4 a1, f32x4 b0, f32x4 b1) const {
    const int b = row / TPB, pos = row - b * TPB; if (pos < CL) return;
    const size_t o = (size_t)(b * SEQ + pos - CL) * 1024 + 256 * pn + c; const float* gt = gate + b * 3072 + 256 * pn + c; const bf16_t* d = D0 + (size_t)row * 1024 + 256 * pn + c;
    float d0[8], d1[8]; ld8bf(d, d0); ld8bf(d + 128, d1);
    const f32x4 x0 = *(const f32x4*)(x + o), x1 = *(const f32x4*)(x + o + 4), x2 = *(const f32x4*)(x + o + 128), x3 = *(const f32x4*)(x + o + 132);
    *(f32x4*)(out + o) = x0 + (f32x4){d0[0], d0[1], d0[2], d0[3]} + a0 * *(const f32x4*)gt;
    *(f32x4*)(out + o + 4) = x1 + (f32x4){d0[4], d0[5], d0[6], d0[7]} + a1 * *(const f32x4*)(gt + 4);
    *(f32x4*)(out + o + 128) = x2 + (f32x4){d1[0], d1[1], d1[2], d1[3]} + b0 * *(const f32x4*)(gt + 128);
    *(f32x4*)(out + o + 132) = x3 + (f32x4){d1[4], d1[5], d1[6], d1[7]} + b1 * *(const f32x4*)(gt + 132); } };

namespace att {
constexpr int NW = 8, QBLK = 32, KVBLK = 64, LDQ = 1536, LDK = 2048, LDKR = 64, LDO = 1024;
constexpr int SHM_V = KVBLK * 128 * 2, SHM_K = KVBLK * 128 * 2, SHM_KR = KVBLK * 64 * 2;
constexpr float THR = 8.f;
#define KSWZ(row, colB) ((row) * 256 + ((colB) ^ (((row) & 7) << 4)))
#define KRSWZ(row, colB) ((row) * 128 + ((colB) ^ (((row) & 7) << 4)))
#define SBAR() __builtin_amdgcn_sched_barrier(0)
__device__ __forceinline__ int crow(int r, int hi) { return (r & 3) + 8 * (r >> 2) + 4 * hi; }
__device__ __forceinline__ unsigned cvtpkv(float lo, float hi) { unsigned r; asm("v_cvt_pk_bf16_f32 %0, %1, %2" : "=v"(r) : "v"(lo), "v"(hi)); return r; }
__device__ __forceinline__ void partialSM(f32x16& p0, f32x16& p1, float& m_reg, float& mn, float& alpha) {
  constexpr float C = 1.4426950408889634f;
  float pmax = p0[0];
#pragma unroll
  for (int r = 1; r < 16; ++r) pmax = fmaxf(pmax, p0[r]);
#pragma unroll
  for (int r = 0; r < 16; ++r) pmax = fmaxf(pmax, p1[r]);
  { auto rr = __builtin_amdgcn_permlane32_swap(__float_as_uint(pmax), __float_as_uint(pmax), false, false);
    pmax = fmaxf(__uint_as_float(rr[0]), __uint_as_float(rr[1])); }
  if (__builtin_expect(__all(pmax - m_reg <= THR), 1)) { mn = m_reg; alpha = 1.f; }
  else { mn = fmaxf(m_reg, pmax); alpha = __builtin_amdgcn_exp2f((m_reg - mn) * C); m_reg = mn; }
  const float mnC = -mn * C;
#pragma unroll
  for (int r = 0; r < 16; ++r) p0[r] = fmaf(p0[r], C, mnC);
#pragma unroll
  for (int r = 0; r < 16; ++r) p1[r] = fmaf(p1[r], C, mnC);
#pragma unroll
  for (int r = 0; r < 16; ++r) p0[r] = __builtin_amdgcn_exp2f(p0[r]);
}
__device__ __forceinline__ void finishSM(f32x16& p0, f32x16& p1, float alpha, float& l_reg, bf16x8& pa0, bf16x8& pa1, bf16x8& pa2, bf16x8& pa3) {
#pragma unroll
  for (int r = 0; r < 16; ++r) p1[r] = __builtin_amdgcn_exp2f(p1[r]);
  float ps = 0;
#pragma unroll
  for (int r = 0; r < 16; ++r) ps += p0[r];
#pragma unroll
  for (int r = 0; r < 16; ++r) ps += p1[r];
  { auto rr = __builtin_amdgcn_permlane32_swap(__float_as_uint(ps), __float_as_uint(ps), false, false);
    ps = __uint_as_float(rr[0]) + __uint_as_float(rr[1]); }
  l_reg = l_reg * alpha + ps;
#define PK4(P, BASE, OUT) do { unsigned a0 = cvtpkv(P[BASE + 0], P[BASE + 1]), a1 = cvtpkv(P[BASE + 2], P[BASE + 3]);   \
    unsigned b0 = cvtpkv(P[BASE + 4], P[BASE + 5]), b1 = cvtpkv(P[BASE + 6], P[BASE + 7]);                              \
    auto r0 = __builtin_amdgcn_permlane32_swap(a0, b0, false, false); auto r1 = __builtin_amdgcn_permlane32_swap(a1, b1, false, false); \
    u32x4 w = {r0[0], r1[0], r0[1], r1[1]}; OUT = *reinterpret_cast<bf16x8*>(&w); } while (0)
  PK4(p0, 0, pa0); PK4(p0, 8, pa1); PK4(p1, 0, pa2); PK4(p1, 8, pa3);
#undef PK4
}
__device__ __forceinline__ void qkt(f32x16& p0, f32x16& p1, const char* Ks, const char* KRs, const bf16x8* qr, int r32, int hi) {
  p0 = f32x16{}; p1 = f32x16{};
#pragma unroll
  for (int d0 = 0; d0 < 8; ++d0) { const int cb = (d0 * 16 + hi * 8) * 2;
    const bf16x8 b0 = *reinterpret_cast<const bf16x8*>(Ks + KSWZ(r32, cb));
    const bf16x8 b1 = *reinterpret_cast<const bf16x8*>(Ks + KSWZ(32 + r32, cb));
    p0 = __builtin_amdgcn_mfma_f32_32x32x16_bf16(b0, qr[d0], p0, 0, 0, 0);
    p1 = __builtin_amdgcn_mfma_f32_32x32x16_bf16(b1, qr[d0], p1, 0, 0, 0); }
#pragma unroll
  for (int d0 = 0; d0 < 4; ++d0) { const int cb = (d0 * 16 + hi * 8) * 2;
    const bf16x8 b0 = *reinterpret_cast<const bf16x8*>(KRs + KRSWZ(r32, cb));
    const bf16x8 b1 = *reinterpret_cast<const bf16x8*>(KRs + KRSWZ(32 + r32, cb));
    p0 = __builtin_amdgcn_mfma_f32_32x32x16_bf16(b0, qr[8 + d0], p0, 0, 0, 0);
    p1 = __builtin_amdgcn_mfma_f32_32x32x16_bf16(b1, qr[8 + d0], p1, 0, 0, 0); }
}
__device__ __forceinline__ int v_st(int k, int c) { const int kk = (k & ~0xC) | ((k & 4) << 1) | ((k & 8) >> 1); return ((kk >> 3) * 4 + (c >> 5)) * 512 + ((kk & 7) * 32 + (c & 31)) * 2; }
__device__ __forceinline__ int v_rd_base(int lane) { return ((lane & 3) << 3) | (((lane >> 2) & 3) << 6) | (((lane >> 4) & 1) << 5) | (((lane >> 5) & 1) << 8); }
constexpr int v_rd_off(int d0, int ks, int half) { return d0 * 512 + ks * 4096 + half * 2048; }
template <int OFF> __device__ __forceinline__ s16x4 tr_read(int vb) {
  s16x4 r; asm volatile("ds_read_b64_tr_b16 %0, %1 offset:%2" : "=&v"(r) : "v"(vb), "i"(OFF) : "memory"); return r;
}
#define PKV(L, H) (bf16x8){L[0], L[1], L[2], L[3], H[0], H[1], H[2], H[3]}
struct VFrag { s16x4 l0, h0, l1, h1, l2, h2, l3, h3; };
template <int D0> __device__ __forceinline__ void pv_read(VFrag& f, int vb) {
  f.l0 = tr_read<v_rd_off(D0, 0, 0)>(vb); f.h0 = tr_read<v_rd_off(D0, 0, 1)>(vb); f.l1 = tr_read<v_rd_off(D0, 1, 0)>(vb); f.h1 = tr_read<v_rd_off(D0, 1, 1)>(vb);
  f.l2 = tr_read<v_rd_off(D0, 2, 0)>(vb); f.h2 = tr_read<v_rd_off(D0, 2, 1)>(vb); f.l3 = tr_read<v_rd_off(D0, 3, 0)>(vb); f.h3 = tr_read<v_rd_off(D0, 3, 1)>(vb); }
__device__ __forceinline__ void pv_mma(f32x16& od, const VFrag& f, bf16x8 pa0, bf16x8 pa1, bf16x8 pa2, bf16x8 pa3) {
  od = __builtin_amdgcn_mfma_f32_32x32x16_bf16(pa0, PKV(f.l0, f.h0), od, 0, 0, 0);
  od = __builtin_amdgcn_mfma_f32_32x32x16_bf16(pa1, PKV(f.l1, f.h1), od, 0, 0, 0);
  od = __builtin_amdgcn_mfma_f32_32x32x16_bf16(pa2, PKV(f.l2, f.h2), od, 0, 0, 0);
  od = __builtin_amdgcn_mfma_f32_32x32x16_bf16(pa3, PKV(f.l3, f.h3), od, 0, 0, 0); }
__device__ __forceinline__ void pv_d0(f32x16* o, int vb, bf16x8 pa0, bf16x8 pa1, bf16x8 pa2, bf16x8 pa3) {
  VFrag fa;
  pv_read<0>(fa, vb); asm volatile("s_waitcnt lgkmcnt(0)" ::: "memory"); SBAR(); pv_mma(o[0], fa, pa0, pa1, pa2, pa3); SBAR();
  pv_read<1>(fa, vb); asm volatile("s_waitcnt lgkmcnt(0)" ::: "memory"); SBAR(); pv_mma(o[1], fa, pa0, pa1, pa2, pa3); SBAR();
  pv_read<2>(fa, vb); asm volatile("s_waitcnt lgkmcnt(0)" ::: "memory"); SBAR(); pv_mma(o[2], fa, pa0, pa1, pa2, pa3); SBAR();
  pv_read<3>(fa, vb); asm volatile("s_waitcnt lgkmcnt(0)" ::: "memory"); SBAR(); pv_mma(o[3], fa, pa0, pa1, pa2, pa3);
}
__device__ __forceinline__ void attn_unit(const bf16_t* __restrict__ Qb, const bf16_t* __restrict__ Kh, const bf16_t* __restrict__ KRh, const bf16_t* __restrict__ Vh,
                                          const bf16_t* __restrict__ Zb, bf16_t* __restrict__ Ob, int seq, char* lds,
                                          const float* __restrict__ gqn, const float* __restrict__ gqr, const float* __restrict__ rtab, int t0, const float* __restrict__ ssq) {
  const int tid = opaque_tid(), wid = tid >> 6, lane = tid & 63, r32 = lane & 31, hi = lane >> 5;
  char* V_lds = lds; char* K_lds = lds + 3 * SHM_V; char* KR_lds = lds + 3 * SHM_V + 3 * SHM_K;
  float* ws = (float*)(lds + 3 * SHM_V + 3 * SHM_K + 3 * SHM_KR) + wid * 64; float* li_l = ws; float* al_l = ws + 32;
  float m_reg = -1e30f, l_reg = 0; f32x16 o[4] = {}; bf16x8 qr[12];
  const bf16_t* Qw = Qb + (long)(wid * QBLK + r32) * LDQ + hi * 8;
#pragma unroll
  for (int d0 = 0; d0 < 12; ++d0) qr[d0] = *reinterpret_cast<const bf16x8*>(Qw + d0 * 16);
  {
    float ssn = 0.f, ssr = 0.f;
#pragma unroll
    for (int d0 = 0; d0 < 12; ++d0) { float f[8]; unpack8(*reinterpret_cast<const u32x4*>(&qr[d0]), f); float t_ = 0.f;
#pragma unroll
      for (int e = 0; e < 8; ++e) t_ += f[e] * f[e];
      if (d0 < 8) ssn += t_; else ssr += t_; }
    { auto rr = __builtin_amdgcn_permlane32_swap(__float_as_uint(ssn), __float_as_uint(ssn), false, false); ssn = __uint_as_float(rr[0]) + __uint_as_float(rr[1]); }
    { auto rr = __builtin_amdgcn_permlane32_swap(__float_as_uint(ssr), __float_as_uint(ssr), false, false); ssr = __uint_as_float(rr[0]) + __uint_as_float(rr[1]); }
    const float rq = rsqrtf(ssq[wid * QBLK + r32] * (1.f / 384.f) + 1e-6f);
    const float rsn = rq * rsqrtf(ssn * rq * rq * (1.f / 128.f) + 1e-6f) * SM_SCALE, rsr = rq * rsqrtf(ssr * rq * rq * (1.f / 64.f) + 1e-6f) * SM_SCALE;
#pragma unroll
    for (int d0 = 0; d0 < 8; ++d0) { float f[8], g[8]; unpack8(*reinterpret_cast<const u32x4*>(&qr[d0]), f); ld8f(gqn + d0 * 16 + hi * 8, g);
#pragma unroll
      for (int e = 0; e < 8; ++e) f[e] *= rsn * g[e];
      const u32x4 w = pack8(f); qr[d0] = *reinterpret_cast<const bf16x8*>(&w); }
    const int tq = t0 + wid * QBLK + r32;
#pragma unroll
    for (int ax = 0; ax < 2; ++ax) { float f1[8], f2[8], g1[8], g2[8], cs[16]; unpack8(*reinterpret_cast<const u32x4*>(&qr[8 + 2 * ax]), f1); unpack8(*reinterpret_cast<const u32x4*>(&qr[9 + 2 * ax]), f2);
      ld8f(gqr + ax * 32 + hi * 8, g1); ld8f(gqr + ax * 32 + 16 + hi * 8, g2);
      const int idx = ax ? (tq & 63) : (tq >> 6); ld8f(rtab + (idx * 16 + hi * 8) * 2, *(float(*)[8])&cs[0]); ld8f(rtab + (idx * 16 + hi * 8) * 2 + 8, *(float(*)[8])&cs[8]);
#pragma unroll
      for (int e = 0; e < 8; ++e) { const float a = f1[e] * rsr * g1[e], b = f2[e] * rsr * g2[e]; f1[e] = a * cs[2 * e] - b * cs[2 * e + 1]; f2[e] = b * cs[2 * e] + a * cs[2 * e + 1]; }
      const u32x4 w1 = pack8(f1), w2 = pack8(f2); qr[8 + 2 * ax] = *reinterpret_cast<const bf16x8*>(&w1); qr[9 + 2 * ax] = *reinterpret_cast<const bf16x8*>(&w2); } }
  const int vb0 = (int)(uintptr_t)V_lds + v_rd_base(lane);
  PG8_LAS unsigned char* l3 = (PG8_LAS unsigned char*)lds; const int wu = __builtin_amdgcn_readfirstlane(wid);
  int offK[2], offV[2], offKR;
#pragma unroll
  for (int i = 0; i < 2; ++i) { const int q = (wid * 2 + i) * 1024 + lane * 16; const int row = q >> 8, colB = (q & 255) ^ ((row & 7) << 4); offK[i] = row * LDK + (colB >> 1);
    const int sub = q >> 9, within = q & 511, kk = (sub >> 2) * 8 + (within >> 6), c = (sub & 3) * 32 + ((within & 63) >> 1), k = (kk & ~0xC) | ((kk & 4) << 1) | ((kk & 8) >> 1); offV[i] = k * LDK + c; }
  { const int q = wid * 1024 + lane * 16; const int row = q >> 7, colB = (q & 127) ^ ((row & 7) << 4); offKR = row * LDKR + (colB >> 1); }
#define SDMA(b, k0) do { _Pragma("unroll") for (int _i = 0; _i < 2; ++_i) { \
      __builtin_amdgcn_global_load_lds((const unsigned*)(Kh + (long)(k0) * LDK + offK[_i]), (PG8_LAS unsigned*)(l3 + 3 * SHM_V + (b) * SHM_K + (wu * 2 + _i) * 1024), 16, 0, 0); \
      __builtin_amdgcn_global_load_lds((const unsigned*)(Vh + (long)(k0) * LDK + offV[_i]), (PG8_LAS unsigned*)(l3 + (b) * SHM_V + (wu * 2 + _i) * 1024), 16, 0, 0); } \
    __builtin_amdgcn_global_load_lds((const unsigned*)(KRh + (long)(k0) * LDKR + offKR), (PG8_LAS unsigned*)(l3 + 3 * SHM_V + 3 * SHM_K + (b) * SHM_KR + wu * 1024), 16, 0, 0); } while (0)
#define SWAIT() asm volatile("s_waitcnt vmcnt(0)" ::: "memory")
#define RESC(a) do { if (__any((a) < 1.f)) { if (hi == 0) al_l[r32] = (a); asm volatile("s_waitcnt lgkmcnt(0)" ::: "memory"); \
    _Pragma("unroll") for (int d = 0; d < 4; ++d) _Pragma("unroll") for (int r = 0; r < 16; ++r) o[d][r] *= al_l[crow(r, hi)]; } } while (0)
  f32x16 pA0, pA1, pB0, pB1; float mnA, mnB, alA, alB; bf16x8 pa0, pa1, pa2, pa3; const int NT = seq / KVBLK;
  int s_prev = 0, s_cur = 1, s_nxt = 2;
#define SGB_QK() do { _Pragma("unroll") for (int i_ = 0; i_ < 24; ++i_) { __builtin_amdgcn_sched_group_barrier(0x008, 1, 0); __builtin_amdgcn_sched_group_barrier(0x100, 1, 0); __builtin_amdgcn_sched_group_barrier(0x002, 4, 0); } } while (0)
#define ABODY(PX0, PX1, mnX, alX, PY0, PY1, alY, jj, LAST) do { \
    SBAR(); qkt(PX0, PX1, K_lds + s_cur * SHM_K, KR_lds + s_cur * SHM_KR, qr, r32, hi); \
    finishSM(PY0, PY1, alY, l_reg, pa0, pa1, pa2, pa3); SGB_QK(); SBAR(); \
    pv_d0(o, vb0 + s_prev * SHM_V, pa0, pa1, pa2, pa3); partialSM(PX0, PX1, m_reg, mnX, alX); \
    SWAIT(); __syncthreads(); \
    RESC(alX); \
    if (!(LAST)) { if ((jj) + 2 < NT) SDMA(s_prev, ((jj) + 2) * KVBLK); \
      const int t_ = s_prev; s_prev = s_cur; s_cur = s_nxt; s_nxt = t_; } } while (0)
  SDMA(0, 0); SDMA(1, KVBLK); SWAIT(); __syncthreads();
  qkt(pA0, pA1, K_lds, KR_lds, qr, r32, hi); partialSM(pA0, pA1, m_reg, mnA, alA);
  SDMA(2, 2 * KVBLK);
  for (int j = 1; j + 1 < NT; j += 2) {
    ABODY(pB0, pB1, mnB, alB, pA0, pA1, alA, j, false);
    ABODY(pA0, pA1, mnA, alA, pB0, pB1, alB, j + 1, false);
  }
  ABODY(pB0, pB1, mnB, alB, pA0, pA1, alA, NT - 1, true);
  finishSM(pB0, pB1, alB, l_reg, pa0, pa1, pa2, pa3); SBAR();
  pv_d0(o, vb0 + s_cur * SHM_V, pa0, pa1, pa2, pa3);
  __syncthreads();
#undef ABODY
  if (hi == 0) li_l[r32] = l_reg; asm volatile("s_waitcnt lgkmcnt(0)" ::: "memory");
  { bf16_t* Ot = (bf16_t*)(lds + wid * 8192);
#pragma unroll
    for (int r = 0; r < 16; ++r) { const int orow = crow(r, hi); const float rl = __builtin_amdgcn_rcpf(li_l[orow]);
#pragma unroll
      for (int d0 = 0; d0 < 4; ++d0) Ot[orow * 128 + d0 * 32 + r32] = (bf16_t)(cvtpk(o[d0][r] * rl, 0.f) & 0xffffu); }
    asm volatile("s_waitcnt lgkmcnt(0)" ::: "memory");
    bf16_t* Ow = Ob + (long)(wid * QBLK) * LDO; const bf16_t* Zw = Zb + (long)(wid * QBLK) * LDO;
#pragma unroll
    for (int i = 0; i < 8; ++i) { const int chunk = i * 64 + lane, row = chunk >> 4, c8 = (chunk & 15) * 8; float ov[8], zv[8];
      ld8bf(Ot + row * 128 + c8, ov); ld8bf(Zw + (long)row * LDO + c8, zv);
#pragma unroll
      for (int e = 0; e < 8; ++e) ov[e] *= zv[e];
      st8bf(Ow + (long)row * LDO + c8, ov); } }
  __syncthreads();
#undef SDMA
#undef SWAIT
#undef RESC
}
}

__device__ __forceinline__ void attn_phase(const Params& p, char* lds) {
  const bf16_t* QR = (const bf16_t*)(p.ws + OFF_QRAW); const bf16_t* KV = (const bf16_t*)(p.ws + OFF_KVRAW); const bf16_t* KR = (const bf16_t*)(p.ws + OFF_KROPE);
  const bf16_t* Z = (const bf16_t*)(p.ws + OFF_Z); bf16_t* OG = (bf16_t*)(p.ws + OFF_OG);
  const int G = gridDim.x, bx = blockIdx.x, vcu = (G % 8 == 0) ? (bx % 8) * (G / 8) + bx / 8 : bx;
  for (int u = vcu; u < NB * 8 * 16; u += G) { const int qb = u & 15, h = (u >> 4) & 7, b = u >> 7; const size_t g0 = (size_t)b * TPB, gq = g0 + CL + qb * 256;
    att::attn_unit(QR + gq * 1536 + h * 192, KV + g0 * 2048 + h * 256, KR + g0 * 64, KV + g0 * 2048 + h * 256 + 128, Z + gq * 1024 + h * 128, OG + gq * 1024 + h * 128, TPB, lds,
                   p.in[25], p.in[26], (const float*)(p.ws + OFF_ROPE), qb * 256, (const float*)(p.ws + OFF_SSQ) + gq); }
}

#define XB_TMO      128
#define XB_XCNT(j)  (256  + 64 * (j))
#define XB_XSUB(j)  (1280 + 64 * (j))
#define XB_XGEN(j)  (2304 + 64 * (j))
#define XB_TOP      3328
#define XB_TOPGEN   3392
#define XCD_BAR_WORDS 3456
#define XB_SPIN_CAP (1u << 18)
#define LAS __attribute__((address_space(3)))

__device__ __forceinline__ unsigned xb_ld(unsigned* p)              { return __hip_atomic_load(p, __ATOMIC_RELAXED, __HIP_MEMORY_SCOPE_AGENT); }
__device__ __forceinline__ unsigned xb_add(unsigned* p, unsigned v) { return __hip_atomic_fetch_add(p, v, __ATOMIC_RELAXED, __HIP_MEMORY_SCOPE_AGENT); }
__device__ __forceinline__ unsigned xb_xcc_id() { return (unsigned)__builtin_amdgcn_s_getreg((3 << 11) | 20) & 0xFu; }
#define XB_SPIN(cond, bar) do { unsigned _sp = 0; while (cond) { __builtin_amdgcn_s_sleep(1); \
    if ((++_sp & 255u) == 0u) { if (xb_ld(&(bar)[XB_TMO])) break; if (_sp > XB_SPIN_CAP) { atomicAdd(&(bar)[XB_TMO], 1u); break; } } } } while (0)

struct XcdBarrier {
    unsigned* bar; unsigned x;
    volatile LAS unsigned* st;
};

__device__ __forceinline__ XcdBarrier xcd_barrier_post(unsigned* bar, volatile LAS unsigned* st) {
    XcdBarrier b; b.bar = bar; b.x = xb_xcc_id(); b.st = st;
    if (threadIdx.x == 0) (void)xb_add(&bar[XB_XCNT(b.x)], 1u);
    return b;
}
__device__ __forceinline__ void xcd_barrier_complete(unsigned* bar, unsigned x, unsigned& nloc, unsigned& nx) {
    const unsigned G = gridDim.x * gridDim.y * gridDim.z;
    unsigned sum, cnt, mine, sp = 0u;
    for (;;) {
        sum = 0u; cnt = 0u; mine = 0u;
#pragma unroll
        for (unsigned j = 0; j < 16; ++j) { const unsigned c = xb_ld(&bar[XB_XCNT(j)]); sum += c; cnt += (c > 0u) ? 1u : 0u; mine = (j == x) ? c : mine; }
        if (sum == G) break;
        __builtin_amdgcn_s_sleep(1);
        if ((++sp & 255u) == 0u) { if (xb_ld(&bar[XB_TMO])) break; if (sp > XB_SPIN_CAP) { atomicAdd(&bar[XB_TMO], 1u); break; } }
    }
    nloc = mine > 0u ? mine : 1u; nx = cnt > 0u ? cnt : 1u;
}

__device__ __forceinline__ void xcd_barrier(const XcdBarrier& b) {
    asm volatile("s_waitcnt vmcnt(0)" ::: "memory");
    __syncthreads();
    if (threadIdx.x == 0) {
        unsigned* bar = b.bar;
        __builtin_amdgcn_s_waitcnt(0);
        unsigned nloc = b.st[0], nx = b.st[1];
        if (nloc == 0u) { xcd_barrier_complete(bar, b.x, nloc, nx); b.st[0] = nloc; b.st[1] = nx; }
        const unsigned old = xb_add(&bar[XB_XSUB(b.x)], 1u);
        const unsigned gen = old / nloc;
        if (old + 1u == (gen + 1u) * nloc) {
            __builtin_amdgcn_fence(__ATOMIC_RELEASE, "agent");
            asm volatile("s_waitcnt vmcnt(0)" ::: "memory");
            const unsigned og = xb_add(&bar[XB_TOP], 1u);
            const unsigned tg = og / nx;
            if (og + 1u == (tg + 1u) * nx) xb_add(&bar[XB_TOPGEN], 1u);
            else XB_SPIN(xb_ld(&bar[XB_TOPGEN]) == tg, bar);
            __builtin_amdgcn_fence(__ATOMIC_ACQUIRE, "agent");
            xb_add(&bar[XB_XGEN(b.x)], 1u);
            asm volatile("s_waitcnt vmcnt(0)" ::: "memory");
        } else {
            XB_SPIN(xb_ld(&bar[XB_XGEN(b.x)]) == gen, bar);
            __builtin_amdgcn_fence(__ATOMIC_ACQUIRE, "agent");
            asm volatile("s_waitcnt vmcnt(0)" ::: "memory");
        }
    }
    __syncthreads();
}


constexpr int LDS_XB_OFF = 155648;
constexpr int LDS_BYTES = LDS_XB_OFF + 256;
#ifndef PHMASK
#define PHMASK 0xFFFF
#endif
#define PH(k) ((PHMASK >> (k)) & 1)
__global__ void __launch_bounds__(512, 2) fwd_megakernel(Params p) {
  extern __shared__ __attribute__((aligned(16))) unsigned char lds[];
  cg::grid_group grid = cg::this_grid();
  PG8_LAS unsigned char* l3 = (PG8_LAS unsigned char*)lds;
  const float* mod = (const float*)(p.ws + OFF_MOD);
  if (threadIdx.x < 4) ((volatile LAS unsigned*)(l3 + LDS_XB_OFF))[threadIdx.x] = 0u;
  __syncthreads();
  XcdBarrier xbar = xcd_barrier_post((unsigned*)(p.ws + OFF_BAR), (volatile LAS unsigned*)(l3 + LDS_XB_OFF));
  if (PH(0)) {
  p0_prologue(p, lds);
  }
  grid.sync();
  if (PH(1)) {
  modnorm_phase(p, 0);
  }
  xcd_barrier(xbar);
  if (PH(2)) {
  { F0 f{(bf16_t*)(p.ws + OFF_CUG), (bf16_t*)(p.ws + OFF_RW), (bf16_t*)(p.ws + OFF_ZB)};
    run_gemm(l3, (const bf16_t*)(p.ws + OFF_H), (const bf16_t*)(p.ws + OFF_W0T), MR, 4352, 1024, f); }
  }
  xcd_barrier(xbar);
  if (PH(3)) {
  rwkv_prep_phase(p);
  }
  xcd_barrier(xbar);
  if (PH(5)) {
  scan_phase(p, lds);
  }
  xcd_barrier(xbar);
  if (PH(6)) {
  even_out_phase(p);
  }
  xcd_barrier(xbar);
  if (PH(7)) {
  { F6 f{(bf16_t*)(p.ws + OFF_DELTA0), mod + 2048};
    run_gemm(l3, (const bf16_t*)(p.ws + OFF_MIX), (const bf16_t*)(p.ws + OFF_WOUT0T), MR, 1024, 1024, f); }
  }
  xcd_barrier(xbar);
  if (PH(8)) {
  modnorm_phase(p, 1);
  }
  xcd_barrier(xbar);
  if (PH(9)) {
  { pg8::Gemm g{(const bf16_t*)(p.ws + OFF_H1), (const bf16_t*)(p.ws + OFF_W1T), MR, 1792, 1024}; pg8::StaticOrder S; S.init(MR, 1792, (int)gridDim.x, (int)blockIdx.x);
    EpiP9 E{p.ws, p.in[22], p.in[28], (PG8_LAS float*)(l3 + 131072)};
    pg8::gemm_phase<EpiP9, pg8::StaticOrder, false>(l3, g, S, E, nullptr); }
  }
  xcd_barrier(xbar);
  if (PH(11)) {
  { FPlain f{(bf16_t*)(p.ws + OFF_QRAW), 1536};
    run_gemm_lat(l3, (const bf16_t*)(p.ws + OFF_P1S), (const bf16_t*)(p.ws + OFF_WQBT), 1536, 384, f); }
  { pg8::Gemm g{(const bf16_t*)(p.ws + OFF_KVAN), (const bf16_t*)(p.ws + OFF_WKVBT), MR, 2048, 256}; pg8::StaticOrder S; S.init(MR, 2048, (int)gridDim.x, (int)blockIdx.x);
    EpiKV E{(bf16_t*)(p.ws + OFF_KVRAW), p.in[27], (PG8_LAS float*)(l3 + 131072)};
    pg8::gemm_phase<EpiKV, pg8::StaticOrder, false>(l3, g, S, E, nullptr); }
  }
  xcd_barrier(xbar);
  if (PH(13)) {
  attn_phase(p, (char*)lds);
  }
  xcd_barrier(xbar);
  if (PH(14)) {
  { F13 f{p.out, p.in[0], (const bf16_t*)(p.ws + OFF_DELTA0), mod + 9 * 3072 + 2048};
    run_gemm_lat(l3, (const bf16_t*)(p.ws + OFF_OG), (const bf16_t*)(p.ws + OFF_WOT), 1024, 1024, f); }
  }
}

extern "C" void kernel_launch(void* const* d_in, const int* in_sizes, int n_in, void* d_out, int out_size, void* d_ws, size_t ws_size, hipStream_t stream) {
  static int grid_blocks = 0;
  if (grid_blocks == 0) {
    if (n_in != 30 || ws_size < WS_NEED || out_size != NB * SEQ * DM) { fprintf(stderr, "kernel_launch: unexpected shapes: n_in %d ws %zu (need %zu) out %d\n", n_in, ws_size, (size_t)WS_NEED, out_size); grid_blocks = -1; return; }
    int dev = 0, cus = 0, per_cu = 0;
    hipGetDevice(&dev); hipDeviceGetAttribute(&cus, hipDeviceAttributeMultiprocessorCount, dev);
    if (hipFuncSetAttribute((const void*)fwd_megakernel, hipFuncAttributeMaxDynamicSharedMemorySize, LDS_BYTES) != hipSuccess) { fprintf(stderr, "kernel_launch: hipFuncSetAttribute failed\n"); grid_blocks = -1; return; }
    hipOccupancyMaxActiveBlocksPerMultiprocessor(&per_cu, (const void*)fwd_megakernel, 512, LDS_BYTES);
    if (per_cu < 1) { fprintf(stderr, "kernel_launch: occupancy query says %d blocks/CU\n", per_cu); per_cu = 1; }
    grid_blocks = cus * 1;
    (void)hipGetLastError();
  }
  if (grid_blocks < 0) return;
  Params p{};
  for (int i = 0; i < 30; ++i) p.in[i] = (const float*)d_in[i];
  p.out = (float*)d_out; p.ws = (unsigned char*)d_ws;
  (void)hipMemsetAsync((unsigned char*)d_ws + OFF_BAR, 0, BAR_BYTES, stream);
  void* args[] = {&p};
  hipError_t e = hipLaunchCooperativeKernel((const void*)fwd_megakernel, dim3(grid_blocks), dim3(512), args, LDS_BYTES, stream);
  if (e != hipSuccess) fprintf(stderr, "cooperative launch failed: %s (grid %d)\n", hipGetErrorString(e), grid_blocks);
}
```
